# Optimizing an MI355X kernel written in HIP

```python
import math
import jax, jax.numpy as jnp
from jax import lax
import numpy as np

D_MODEL = 2048
BATCH = 4
SEQ = 2048
DEPTH = 4
DEC_BATCH = 128
DEC_SEQ = 4
PAST_LEN = 16384
PAGE_SIZE = 128

N_EVEN = (DEPTH + 1) // 2
N_ODD = DEPTH // 2
D_RET = D_MODEL // 2
H_RET = 4
DK_RET = D_RET // H_RET
DV_RET = D_RET // H_RET
RET_CHUNK = 128
ROPE_BASE = 10000.0
D_RG = D_MODEL // 2
RG_BLOCKS = 8
RG_BW = D_RG // RG_BLOCKS
RG_CONV = 4
RG_C = 8.0
D_HG = D_MODEL
HG_DK = 128
H_HG = D_HG // HG_DK
HG_DV = D_HG // H_HG
HG_CHUNK = 32
D_FF = 5632
FFN_CONV = 3
DN_ALPHA = (2 * DEPTH) ** 0.25
DN_BETA = (8 * DEPTH) ** -0.25
LN_EPS = 1e-5
NORM_EPS = 1e-6

EVEN_IN = 4 * D_RET + 2 * D_RG
ODD_IN = 4 * D_HG

kernel_name = "hybrid_retention_rglru_hgrn2_step"

F32 = jnp.float32


def _layer_norm(x, g, b):
    xf = x.astype(F32)
    mu = xf.mean(-1, keepdims=True)
    var = jnp.square(xf - mu).mean(-1, keepdims=True)
    return ((xf - mu) * lax.rsqrt(var + LN_EPS) * g.astype(F32) + b.astype(F32)).astype(x.dtype)


def _rms_norm(x):
    xf = x.astype(F32)
    return xf * lax.rsqrt(jnp.mean(xf * xf, axis=-1, keepdims=True) + NORM_EPS)


def _rotary(x, pos):
    half = x.shape[-1] // 2
    inv = ROPE_BASE ** (-jnp.arange(half, dtype=F32) / half)
    ang = pos.astype(F32)[:, None] * inv[None, :]
    cos = jnp.cos(ang)[None, :, None, :]
    sin = jnp.sin(ang)[None, :, None, :]
    xf = x.astype(F32)
    x1, x2 = xf[..., :half], xf[..., half:]
    return jnp.concatenate([x1 * cos - x2 * sin, x2 * cos + x1 * sin], axis=-1)


def _causal_dwconv(x, buf, w, b):
    T = x.shape[1]
    W = w.shape[0]
    xp = jnp.concatenate([buf.astype(x.dtype), x], axis=1)
    y = xp[:, 0:T] * w[0] + b
    for j in range(1, W):
        y = y + xp[:, j:j + T] * w[j]
    return y, xp[:, xp.shape[1] - (W - 1):]


def _chunk_len(T, chunk):
    return chunk if T % chunk == 0 else T


def _to_chunks(a, N, C):
    B, T, H, d = a.shape
    return a.reshape(B, N, C, H, d).transpose(1, 0, 3, 2, 4)


def _from_chunks(o):
    N, B, H, C, d = o.shape
    return o.transpose(1, 0, 3, 2, 4).reshape(B, N * C, H, d)


def _retention(q, k, v, S0, chunk):
    B, T, H, _ = q.shape
    C = _chunk_len(T, chunk)
    N = T // C
    lg = jnp.log(1.0 - 2.0 ** (-5.0 - jnp.arange(H, dtype=F32)))
    idx = jnp.arange(C, dtype=F32)
    diff = idx[:, None] - idx[None, :]
    dmask = jnp.where(diff[None] >= 0, jnp.exp(jnp.maximum(diff, 0.0)[None] * lg[:, None, None]), 0.0)
    xi = jnp.exp((idx[None, :] + 1.0) * lg[:, None])[None, :, :, None]
    zeta = jnp.exp((C - 1.0 - idx[None, :]) * lg[:, None])[None, :, :, None]
    cdec = jnp.exp(C * lg)[None, :, None, None]

    def step(S, inp):
        qc, kc, vc = inp
        inner = jnp.einsum('bhtk,bhsk->bhts', qc, kc) * dmask[None]
        o = jnp.einsum('bhts,bhsv->bhtv', inner, vc) + jnp.einsum('bhtk,bhkv->bhtv', qc, S) * xi
        S = S * cdec + jnp.einsum('bhsk,bhsv->bhkv', kc * zeta, vc)
        return S, o

    S, o = lax.scan(step, S0, (_to_chunks(q, N, C), _to_chunks(k, N, C), _to_chunks(v, N, C)))
    return _from_chunks(o), S


def _gla(q, k, v, logf, S0, chunk):
    B, T, H, _ = q.shape
    C = _chunk_len(T, chunk)
    N = T // C
    causal = jnp.tril(jnp.ones((C, C), dtype=bool))

    def step(S, inp):
        qc, kc, vc, gc = inp
        b = jnp.cumsum(gc, axis=2)
        diff = b[:, :, :, None, :] - b[:, :, None, :, :]
        decay = jnp.exp(jnp.where(causal[None, None, :, :, None], diff, -jnp.inf))
        A = jnp.einsum('bhtk,bhsk,bhtsk->bhts', qc, kc, decay)
        o = jnp.einsum('bhts,bhsv->bhtv', A, vc) + jnp.einsum('bhtk,bhkv->bhtv', qc * jnp.exp(b), S)
        b_last = b[:, :, -1:, :]
        S = S * jnp.exp(b_last[:, :, 0, :])[..., None] + jnp.einsum('bhsk,bhsv->bhkv', kc * jnp.exp(b_last - b), vc)
        return S, o

    S, o = lax.scan(step, S0, (_to_chunks(q, N, C), _to_chunks(k, N, C), _to_chunks(v, N, C), _to_chunks(logf, N, C)))
    return _from_chunks(o), S


def _rglru(xc, pos, h0, wa, ba, wx, bx, lam):
    B, T, D = xc.shape
    xb = xc.reshape(B, T, RG_BLOCKS, RG_BW)
    r = jax.nn.sigmoid((jnp.einsum('btni,nij->btnj', xb, wa).reshape(B, T, D) + ba).astype(F32))
    i = jax.nn.sigmoid((jnp.einsum('btni,nij->btnj', xb, wx).reshape(B, T, D) + bx).astype(F32))
    log_a = -RG_C * r * jax.nn.softplus(-lam.astype(F32))
    a = jnp.exp(log_a)
    mult = jnp.sqrt(-jnp.expm1(2.0 * log_a))
    mult = jnp.where((pos == 0)[None, :, None], 1.0, mult)
    bterm = xc.astype(F32) * i * mult
    bterm = bterm.at[:, 0].add(a[:, 0] * h0.astype(F32))

    def comb(l, rr):
        return (l[0] * rr[0], rr[0] * l[1] + rr[1])

    _, h = lax.associative_scan(comb, (a, bterm), axis=1)
    return h, h[:, -1]


def _even_mixer(x, pos, S_ret, h_rg, buf_rg, w_in, w_out, cw, cb, wa, ba, wx, bx, lam):
    B, T, _ = x.shape
    dt = x.dtype
    q, k, v, g, xr, gr = jnp.split(x @ w_in, [D_RET, 2 * D_RET, 3 * D_RET, 4 * D_RET, 4 * D_RET + D_RG], axis=-1)
    q = _rotary(q.reshape(B, T, H_RET, DK_RET), pos)
    k = _rotary(k.reshape(B, T, H_RET, DK_RET), pos) * (DK_RET ** -0.5)
    v = v.reshape(B, T, H_RET, DV_RET).astype(F32)
    o, S_new = _retention(q, k, v, S_ret.astype(F32), RET_CHUNK)
    o_ret = _rms_norm(o).reshape(B, T, D_RET) * jax.nn.silu(g.astype(F32))
    xc, buf_new = _causal_dwconv(xr, buf_rg, cw, cb)
    h, h_last = _rglru(xc, pos, h_rg, wa, ba, wx, bx, lam)
    o_rg = h * jax.nn.gelu(gr.astype(F32))
    mixed = jnp.concatenate([o_ret, o_rg], axis=-1).astype(dt)
    return (mixed @ w_out, S_new.astype(S_ret.dtype), h_last.astype(h_rg.dtype), buf_new.astype(buf_rg.dtype))


def _odd_mixer(x, S_hg, w_in, w_out, norm_g, lb):
    B, T, _ = x.shape
    dt = x.dtype
    q, f, i, g = jnp.split(x @ w_in, 4, axis=-1)
    q = jax.nn.silu(q.astype(F32))
    fg = lb.astype(F32) + (1.0 - lb.astype(F32)) * jax.nn.sigmoid(f.astype(F32))
    logf = jnp.log(fg)
    kk = 1.0 - fg
    o, S_new = _gla(q.reshape(B, T, H_HG, HG_DK), kk.reshape(B, T, H_HG, HG_DK),
                    i.astype(F32).reshape(B, T, H_HG, HG_DV), logf.reshape(B, T, H_HG, HG_DK),
                    S_hg.astype(F32), HG_CHUNK)
    o = (_rms_norm(o) * norm_g.astype(F32)).reshape(B, T, D_HG) * jax.nn.sigmoid(g.astype(F32))
    return o.astype(dt) @ w_out, S_new.astype(S_hg.dtype)


def _conv_ffn(x, buf, w_up, cw, cb, w_down):
    u, v = jnp.split(x @ w_up, 2, axis=-1)
    uc, buf_new = _causal_dwconv(u, buf, cw, cb)
    return (jax.nn.gelu(uc) * v) @ w_down, buf_new.astype(buf.dtype)


def _trunk(x, pos, s_ret, s_h, s_conv, s_hg, s_ffc, w, lb):
    n_ret, n_h, n_conv, n_hg, n_ffc = [], [], [], [], []
    for l in range(DEPTH):
        if l % 2 == 0:
            e = l // 2
            mix, sr, sh, sc = _even_mixer(x, pos, s_ret[e], s_h[e], s_conv[e], w['ev_w_in'][e], w['ev_w_out'][e],
                                          w['ev_rg_conv_w'][e], w['ev_rg_conv_b'][e], w['ev_rg_wa'][e], w['ev_rg_ba'][e],
                                          w['ev_rg_wx'][e], w['ev_rg_bx'][e], w['ev_rg_lambda'][e])
            n_ret.append(sr); n_h.append(sh); n_conv.append(sc)
        else:
            o = l // 2
            mix, sg = _odd_mixer(x, s_hg[o], w['od_w_in'][o], w['od_w_out'][o], w['od_norm_g'][o], lb[o])
            n_hg.append(sg)
        x = _layer_norm(DN_ALPHA * x + mix, w['ln_g'][l, 0], w['ln_b'][l, 0])
        f, fc = _conv_ffn(x, s_ffc[l], w['ffn_w_up'][l], w['ffn_conv_w'][l], w['ffn_conv_b'][l], w['ffn_w_down'][l])
        n_ffc.append(fc)
        x = _layer_norm(DN_ALPHA * x + f, w['ln_g'][l, 1], w['ln_b'][l, 1])
    return x, (jnp.stack(n_ret), jnp.stack(n_h), jnp.stack(n_conv), jnp.stack(n_hg), jnp.stack(n_ffc))


def setup_inputs(seed: int = 0) -> dict:
    key = jax.random.key(seed)
    ks = jax.random.split(key, 32)
    nrm = lambda k, s, sc: jax.random.normal(k, s, F32) * sc
    a0 = jax.random.uniform(ks[13], (N_EVEN, D_RG), F32, minval=0.9, maxval=0.999)
    s0 = a0 ** (1.0 / RG_C)
    lam = jnp.log(s0) - jnp.log1p(-s0)
    return {
        'x_prompt': nrm(ks[0], (BATCH, SEQ, D_MODEL), 1.0),
        'x_sample': nrm(ks[1], (DEC_BATCH, DEC_SEQ, D_MODEL), 1.0),
        'state_ret': nrm(ks[2], (N_EVEN, DEC_BATCH, H_RET, DK_RET, DV_RET), 0.1),
        'state_rglru_h': nrm(ks[3], (N_EVEN, DEC_BATCH, D_RG), 0.5),
        'state_rglru_conv': nrm(ks[4], (N_EVEN, DEC_BATCH, RG_CONV - 1, D_RG), 1.0),
        'state_hgrn': nrm(ks[5], (N_ODD, DEC_BATCH, H_HG, HG_DK, HG_DV), 0.1),
        'state_ffn_conv': nrm(ks[6], (DEPTH, DEC_BATCH, FFN_CONV - 1, D_FF), 1.0),
        'ev_w_in': nrm(ks[7], (N_EVEN, D_MODEL, EVEN_IN), D_MODEL ** -0.5),
        'ev_w_out': nrm(ks[8], (N_EVEN, D_RET + D_RG, D_MODEL), (D_RET + D_RG) ** -0.5 * DN_BETA),
        'ev_rg_conv_w': nrm(ks[9], (N_EVEN, RG_CONV, D_RG), RG_CONV ** -0.5),
        'ev_rg_conv_b': nrm(ks[10], (N_EVEN, D_RG), 0.01),
        'ev_rg_wa': nrm(ks[11], (N_EVEN, RG_BLOCKS, RG_BW, RG_BW), RG_BW ** -0.5),
        'ev_rg_ba': nrm(ks[12], (N_EVEN, D_RG), 0.01),
        'ev_rg_wx': nrm(ks[14], (N_EVEN, RG_BLOCKS, RG_BW, RG_BW), RG_BW ** -0.5),
        'ev_rg_bx': nrm(ks[15], (N_EVEN, D_RG), 0.01),
        'ev_rg_lambda': lam,
        'od_w_in': nrm(ks[16], (N_ODD, D_MODEL, ODD_IN), D_MODEL ** -0.5),
        'od_w_out': nrm(ks[17], (N_ODD, D_HG, D_MODEL), D_HG ** -0.5 * DN_BETA),
        'od_norm_g': 1.0 + nrm(ks[18], (N_ODD, HG_DV), 0.01),
        'od_lb_logits': nrm(ks[19], (N_ODD, D_HG), 0.1),
        'ln_g': 1.0 + nrm(ks[20], (DEPTH, 2, D_MODEL), 0.01),
        'ln_b': nrm(ks[21], (DEPTH, 2, D_MODEL), 0.01),
        'ffn_w_up': nrm(ks[22], (DEPTH, D_MODEL, 2 * D_FF), D_MODEL ** -0.5),
        'ffn_conv_w': nrm(ks[23], (DEPTH, FFN_CONV, D_FF), FFN_CONV ** -0.5),
        'ffn_conv_b': nrm(ks[24], (DEPTH, D_FF), 0.01),
        'ffn_w_down': nrm(ks[25], (DEPTH, D_FF, D_MODEL), D_FF ** -0.5 * DN_BETA),
    }


def reference(x_prompt, x_sample, state_ret, state_rglru_h, state_rglru_conv, state_hgrn, state_ffn_conv,
              ev_w_in, ev_w_out, ev_rg_conv_w, ev_rg_conv_b, ev_rg_wa, ev_rg_ba, ev_rg_wx, ev_rg_bx, ev_rg_lambda,
              od_w_in, od_w_out, od_norm_g, od_lb_logits, ln_g, ln_b, ffn_w_up, ffn_conv_w, ffn_conv_b, ffn_w_down):
    w = {'ev_w_in': ev_w_in, 'ev_w_out': ev_w_out, 'ev_rg_conv_w': ev_rg_conv_w, 'ev_rg_conv_b': ev_rg_conv_b,
         'ev_rg_wa': ev_rg_wa, 'ev_rg_ba': ev_rg_ba, 'ev_rg_wx': ev_rg_wx, 'ev_rg_bx': ev_rg_bx,
         'ev_rg_lambda': ev_rg_lambda, 'od_w_in': od_w_in, 'od_w_out': od_w_out, 'od_norm_g': od_norm_g,
         'ln_g': ln_g, 'ln_b': ln_b, 'ffn_w_up': ffn_w_up, 'ffn_conv_w': ffn_conv_w,
         'ffn_conv_b': ffn_conv_b, 'ffn_w_down': ffn_w_down}
    p = jax.nn.softmax(od_lb_logits.astype(F32), axis=0)
    lb = jnp.cumsum(p, axis=0) - p[0:1]

    Bp, Tp, _ = x_prompt.shape
    dt = x_prompt.dtype
    pos_p = jnp.arange(Tp, dtype=jnp.int32)
    pos_s = PAST_LEN + jnp.arange(x_sample.shape[1], dtype=jnp.int32)
    z_ret = jnp.zeros((N_EVEN, Bp, H_RET, DK_RET, DV_RET), dt)
    z_h = jnp.zeros((N_EVEN, Bp, D_RG), dt)
    z_conv = jnp.zeros((N_EVEN, Bp, RG_CONV - 1, D_RG), dt)
    z_hg = jnp.zeros((N_ODD, Bp, H_HG, HG_DK, HG_DV), dt)
    z_ffc = jnp.zeros((DEPTH, Bp, FFN_CONV - 1, D_FF), dt)

    y_prompt, (rp, hp, cp, gp, fp) = _trunk(x_prompt, pos_p, z_ret, z_h, z_conv, z_hg, z_ffc, w, lb)
    y_sample, (rs, hs, cs, gs, fs) = _trunk(x_sample, pos_s, state_ret, state_rglru_h, state_rglru_conv,
                                            state_hgrn, state_ffn_conv, w, lb)
    return (y_prompt, y_sample, rp, rs, hp, hs, cp, cs, gp, gs, fp, fs)
```

```cpp
#include <hip/hip_runtime.h>
#include <cstdio>
#include <cstdint>
#include <cstddef>
namespace pg8 {
#define PG8_LAS __attribute__((address_space(3)))
typedef unsigned short bf16_t;
typedef short bf16x8 __attribute__((ext_vector_type(8)));
typedef float f32x4 __attribute__((ext_vector_type(4)));
typedef unsigned u32x4 __attribute__((ext_vector_type(4)));
constexpr int BM = 256, BK = 64, HALF = 128, HTB = HALF * BK * 2  , STAGE_BYTES = 8 * HTB, NXCD = 8, WGM = 8;

__host__ __device__ __forceinline__ int lds_byte(int r, int c) { const int st = (r >> 4) * 2 + (c >> 5), rr = r & 15, cc = c & 31, ob = rr * 64 + cc * 2; return st * 1024 + (ob ^ (((ob >> 9) & 1) << 5)); }
__host__ __device__ __forceinline__ void stage_rc(int b, int& R, int& C) { const int st = b / 1024, sb = b % 1024, swz = sb ^ (((sb >> 9) & 1) << 5); R = (st >> 1) * 16 + swz / 64; C = (st & 1) * 32 + (swz % 64) / 2; }
__host__ __device__ __forceinline__ int perm32(int rho) { const int n = rho >> 4, i = rho & 15; return 8 * (i >> 2) + 4 * n + (i & 3); }

struct Unit { int pm, pn; };
struct Gemm { const bf16_t* A; const bf16_t* Bt; int M, N, K; };

struct StaticOrder {
    int nM, nN, nwg, G, c;
    __host__ __device__ void init(int M, int N, int G_, int c_) { nM = M / BM; nN = N / BM; nwg = nM * nN; G = G_; c = c_; }
    __host__ __device__ bool next(int i, Unit& u) const {
        const long L = (long)i * G + c; if (L >= nwg) return false;
        int wgid = (int)L; { const int q = nwg / NXCD, r = nwg % NXCD, xcd = wgid % NXCD, off = wgid / NXCD; wgid = (xcd < r ? xcd * (q + 1) : r * (q + 1) + (xcd - r) * q) + off; }
        const int nig = WGM * nN, gid = wgid / nig, fm = gid * WGM, gsz = (nM - fm) < WGM ? (nM - fm) : WGM;
        u.pm = fm + ((wgid % nig) % gsz); u.pn = (wgid % nig) / gsz; return true;
    }
    __device__ __forceinline__ void a_ready(const Unit&) const {}
    __device__ __forceinline__ void done(const Unit&) const {}
};
__device__ __forceinline__ unsigned cvt_pk_bf16(float lo, float hi) { unsigned r; asm volatile("v_cvt_pk_bf16_f32 %0, %1, %2" : "=v"(r) : "v"(lo), "v"(hi)); return r; }
typedef float f32x2 __attribute__((ext_vector_type(2)));
__device__ __forceinline__ f32x2 gelu_pk(f32x2 v) {
    const f32x2 av = __builtin_elementwise_abs(v), d = av * 0.2316418882f + 1.0f;
    f32x2 t; t.x = __builtin_amdgcn_rcpf(d.x); t.y = __builtin_amdgcn_rcpf(d.y);
    f32x2 q = t * 0.5307027145f + (-0.7265760135f); q = q * t + 0.7107068705f; q = q * t + (-0.142248368f); q = q * t + 0.127414796f; q = q * t;
    const f32x2 s = (v * v) * (-0.72134752044f);
    f32x2 e; e.x = __builtin_amdgcn_exp2f(s.x); e.y = __builtin_amdgcn_exp2f(s.y);
    const f32x2 m = v * (q * e), r = v - m;
    f32x2 o; o.x = v.x < 0.f ? m.x : r.x; o.y = v.y < 0.f ? m.y : r.y; return o;
}

template <int ACT  > struct EpiBf16 {
    static constexpr bool PERM = true, AFTER_DRAIN = false; static_assert(ACT == 0 || ACT == 1, "EpiBf16: ACT is 0 (none) or 1 (gelu_pk)");
    bf16_t* O; int ldc; const float* bias; int split_cols; size_t split_stride; float scale0;
    __device__ __forceinline__ void operator()(const f32x4 (&acc)[2][2][4][2], const Unit& u, int wr, int wc, int fr, int fq) const {
        const int row0 = u.pm * BM + wr * 64 + fr; int colt = u.pn * BM; bf16_t* base = O;
        float sc = 1.f; if (split_cols) { const int t = colt / split_cols; base += (size_t)t * split_stride; colt -= t * split_cols; if (t == 0) sc = scale0; }
        const int col0 = colt + wc * 32 + 8 * fq, bcol0 = u.pn * BM + wc * 32 + 8 * fq;
        f32x4 bv[2][2];
#pragma unroll
        for (int bj = 0; bj < 2; ++bj)
#pragma unroll
            for (int n = 0; n < 2; ++n) bv[bj][n] = bias ? *(const f32x4*)(bias + bcol0 + bj * HALF + 4 * n) : (f32x4){0.f, 0.f, 0.f, 0.f};
#pragma unroll
        for (int ai = 0; ai < 2; ++ai)
#pragma unroll
            for (int m = 0; m < 4; ++m) { bf16_t* rowp = base + (size_t)(row0 + ai * HALF + m * 16) * ldc + col0;
#pragma unroll
                for (int bj = 0; bj < 2; ++bj) { f32x4 v0 = acc[ai][bj][m][0] + bv[bj][0], v1 = acc[ai][bj][m][1] + bv[bj][1];
                    if (ACT == 1) { f32x2 a = gelu_pk((f32x2){v0[0], v0[1]}), b = gelu_pk((f32x2){v0[2], v0[3]}), c = gelu_pk((f32x2){v1[0], v1[1]}), d = gelu_pk((f32x2){v1[2], v1[3]});
                        v0 = (f32x4){a.x, a.y, b.x, b.y}; v1 = (f32x4){c.x, c.y, d.x, d.y}; }
                    v0 = v0 * sc; v1 = v1 * sc; u32x4 w; w.x = cvt_pk_bf16(v0[0], v0[1]); w.y = cvt_pk_bf16(v0[2], v0[3]); w.z = cvt_pk_bf16(v1[0], v1[1]); w.w = cvt_pk_bf16(v1[2], v1[3]);
                    *(u32x4*)(rowp + bj * HALF) = w; } }
    }
};
struct EpiF32 {
    static constexpr bool PERM = false, AFTER_DRAIN = false;
    float* C; int ldc; const float* bias;
    __device__ __forceinline__ void operator()(const f32x4 (&acc)[2][2][4][2], const Unit& u, int wr, int wc, int fr, int fq) const {
        const int row0 = u.pm * BM + wr * 64 + fr, col0 = u.pn * BM + wc * 32 + 4 * fq;
        f32x4 bv[2][2];
#pragma unroll
        for (int bj = 0; bj < 2; ++bj)
#pragma unroll
            for (int n = 0; n < 2; ++n) bv[bj][n] = bias ? *(const f32x4*)(bias + col0 + bj * HALF + n * 16) : (f32x4){0.f, 0.f, 0.f, 0.f};
#pragma unroll
        for (int ai = 0; ai < 2; ++ai)
#pragma unroll
            for (int m = 0; m < 4; ++m) { float* rowp = C + (size_t)(row0 + ai * HALF + m * 16) * ldc + col0;
#pragma unroll
                for (int bj = 0; bj < 2; ++bj)
#pragma unroll
                    for (int n = 0; n < 2; ++n) *(f32x4*)(rowp + bj * HALF + n * 16) = acc[ai][bj][m][n] + bv[bj][n]; }
    }
};
struct EpiEvenIn {
    static constexpr bool PERM = true, AFTER_DRAIN = false;
    bf16_t* O; int ldc; const float* rcos; const float* rsin;
    __device__ __forceinline__ void operator()(const f32x4 (&acc)[2][2][4][2], const Unit& u, int wr, int wc, int fr, int fq) const {
        const int row0 = u.pm * BM + wr * 64 + fr; const int col0 = u.pn * BM + wc * 32 + 8 * fq;
        if (u.pn < 8) {
            const float sc = (u.pn >= 4) ? 0.0625f : 1.0f; const int j0 = wc * 32 + 8 * fq;
#pragma unroll
            for (int ai = 0; ai < 2; ++ai)
#pragma unroll
                for (int m = 0; m < 4; ++m) { const int row = row0 + ai * HALF + m * 16; const int pidx = row < 8192 ? (row & 2047) : 2048 + (row & 3);
                    const float* cp = rcos + pidx * 128 + j0; const float* sp = rsin + pidx * 128 + j0;
                    const f32x4 c0 = *(const f32x4*)cp, c1 = *(const f32x4*)(cp + 4), s0 = *(const f32x4*)sp, s1 = *(const f32x4*)(sp + 4);
                    const f32x4 a0 = acc[ai][0][m][0], a1 = acc[ai][0][m][1], b0 = acc[ai][1][m][0], b1 = acc[ai][1][m][1];
                    const f32x4 o10 = (a0 * c0 - b0 * s0) * sc, o11 = (a1 * c1 - b1 * s1) * sc, o20 = (b0 * c0 + a0 * s0) * sc, o21 = (b1 * c1 + a1 * s1) * sc;
                    bf16_t* rowp = O + (size_t)row * ldc + col0;
                    u32x4 w; w.x = cvt_pk_bf16(o10[0], o10[1]); w.y = cvt_pk_bf16(o10[2], o10[3]); w.z = cvt_pk_bf16(o11[0], o11[1]); w.w = cvt_pk_bf16(o11[2], o11[3]);
                    *(u32x4*)(rowp) = w;
                    w.x = cvt_pk_bf16(o20[0], o20[1]); w.y = cvt_pk_bf16(o20[2], o20[3]); w.z = cvt_pk_bf16(o21[0], o21[1]); w.w = cvt_pk_bf16(o21[2], o21[3]);
                    *(u32x4*)(rowp + HALF) = w; }
        } else {
#pragma unroll
            for (int ai = 0; ai < 2; ++ai)
#pragma unroll
                for (int m = 0; m < 4; ++m) { bf16_t* rowp = O + (size_t)(row0 + ai * HALF + m * 16) * ldc + col0;
#pragma unroll
                    for (int bj = 0; bj < 2; ++bj) { const f32x4 v0 = acc[ai][bj][m][0], v1 = acc[ai][bj][m][1];
                        u32x4 w; w.x = cvt_pk_bf16(v0[0], v0[1]); w.y = cvt_pk_bf16(v0[2], v0[3]); w.z = cvt_pk_bf16(v1[0], v1[1]); w.w = cvt_pk_bf16(v1[2], v1[3]);
                        *(u32x4*)(rowp + bj * HALF) = w; } }
        }
    }
};
template <class Epi, class Sched, bool ALIGN_EPI = false, bool SP2 = false>
__device__ __forceinline__ void gemm_phase(PG8_LAS unsigned char* lds, const Gemm g, const Sched& S, const Epi& E) {
    int tid_ = threadIdx.x; asm volatile("" : "+v"(tid_));
    const int tid = tid_, wid = __builtin_amdgcn_readfirstlane(tid >> 6), lane = tid & 63, wr = wid >> 2, wc = wid & 3, fr = lane & 15, fq = lane >> 4;
    const int K = g.K, nt = K / BK;
    unsigned voffA[2], voffB[2];
#pragma unroll
    for (int i = 0; i < 2; ++i) { int R, C; stage_rc(tid * 16 + i * 8192, R, C); const int Rb = Epi::PERM ? ((R & ~31) + perm32(R & 31)) : R;
        voffA[i] = (unsigned)(R * K + C) * 2u; voffB[i] = (unsigned)(Rb * K + C) * 2u; }
    const size_t kstep = (size_t)(BK * 2);
    const size_t hstep = (size_t)HALF * K * 2;
    const size_t tstep = 2 * hstep;
    const unsigned ldsw = (unsigned)wid * 1024u;
    const int aoff = lds_byte(wr * 64 + fr, fq * 8), boff = lds_byte(wc * 32 + fr, fq * 8);
#define PG8_SA(b, h) (((b) * 2 + (h)) * HTB)
#define PG8_SB(b, h) ((4 + (b) * 2 + (h)) * HTB)
#define PG8_STAGE(bufoff, gbase, voff) do { _Pragma("unroll") for (int _i = 0; _i < 2; ++_i) \
        __builtin_amdgcn_global_load_lds((const unsigned*)((const char*)(gbase) + (voff)[_i]), (PG8_LAS unsigned*)(lds + (bufoff) + ldsw + _i * 8192), 16, 0, 0); } while (0)
#define PG8_LDA(dst, b, h) do { _Pragma("unroll") for (int m = 0; m < 4; ++m) _Pragma("unroll") for (int k = 0; k < 2; ++k) dst[m][k] = *(const PG8_LAS bf16x8*)(lds + PG8_SA(b, h) + aoff + m * 2048 + k * 1024); } while (0)
#define PG8_LDB(dst, b, h) do { _Pragma("unroll") for (int n = 0; n < 2; ++n) _Pragma("unroll") for (int k = 0; k < 2; ++k) dst[n][k] = *(const PG8_LAS bf16x8*)(lds + PG8_SB(b, h) + boff + n * 2048 + k * 1024); } while (0)
#define PG8_MMA(ai, bj, At, Bt) do { __builtin_amdgcn_s_setprio(1); _Pragma("unroll") for (int m = 0; m < 4; ++m) _Pragma("unroll") for (int n = 0; n < 2; ++n) _Pragma("unroll") for (int k = 0; k < 2; ++k) \
        acc[ai][bj][m][n] = __builtin_amdgcn_mfma_f32_16x16x32_bf16(Bt[n][k], At[m][k], acc[ai][bj][m][n], 0, 0, 0); __builtin_amdgcn_s_setprio(0); } while (0)
#define PG8_WAIT_V(n) asm volatile("s_waitcnt vmcnt(" #n ")" ::: "memory")
#define PG8_WAIT_L(n) asm volatile("s_waitcnt lgkmcnt(" #n ")" ::: "memory")
#define PG8_BAR __builtin_amdgcn_s_barrier()
#define PG8_SCHED __builtin_amdgcn_sched_barrier(0)
    Unit cur, nxt; int ui = 0;
    if (!S.next(0, cur)) return;
    f32x4 acc[2][2][4][2];
#pragma unroll
    for (int a = 0; a < 2; ++a)
#pragma unroll
        for (int b = 0; b < 2; ++b)
#pragma unroll
            for (int m = 0; m < 4; ++m)
#pragma unroll
                for (int n = 0; n < 2; ++n) acc[a][b][m][n] = (f32x4){0.f, 0.f, 0.f, 0.f};
    bf16x8 At[4][2], B0[2][2], B1[2][2];
    const char* cA = (const char*)g.A + (size_t)cur.pm * tstep; const char* cB = (const char*)g.Bt + (size_t)cur.pn * tstep;
    S.a_ready(cur);
    if constexpr (SP2) {
        PG8_STAGE(PG8_SB(0, 0), cB, voffB); PG8_STAGE(PG8_SB(0, 1), cB + hstep, voffB); PG8_STAGE(PG8_SA(0, 0), cA, voffA); PG8_STAGE(PG8_SA(0, 1), cA + hstep, voffA);
        if (wr == 1) PG8_BAR;
        PG8_WAIT_V(2); PG8_BAR;
        PG8_STAGE(PG8_SB(1, 0), cB + kstep, voffB); PG8_STAGE(PG8_SA(1, 0), cA + kstep, voffA); PG8_STAGE(PG8_SB(1, 1), cB + hstep + kstep, voffB);
        PG8_WAIT_V(6); PG8_BAR;
    } else {
        PG8_STAGE(PG8_SB(0, 0), cB, voffB); PG8_STAGE(PG8_SA(0, 0), cA, voffA); PG8_STAGE(PG8_SB(0, 1), cB + hstep, voffB); PG8_STAGE(PG8_SA(0, 1), cA + hstep, voffA);
        if (wr == 1) PG8_BAR;
        PG8_WAIT_V(4); PG8_BAR;
        PG8_STAGE(PG8_SB(1, 0), cB + kstep, voffB); PG8_STAGE(PG8_SA(1, 0), cA + kstep, voffA); PG8_STAGE(PG8_SB(1, 1), cB + hstep + kstep, voffB);
        PG8_WAIT_V(6); PG8_BAR;
    }
    for (;;) {
        const bool has_next = S.next(ui + 1, nxt);
        const char* nA = has_next ? (const char*)g.A + (size_t)nxt.pm * tstep : cA; const char* nB = has_next ? (const char*)g.Bt + (size_t)nxt.pn * tstep : cB;
        for (int t = 0; t < nt; t += 2) {
            const bool last = (t == nt - 2);
            const char* a1 = cA + (size_t)(t + 1) * kstep;
            const char* a2 = last ? nA : cA + (size_t)(t + 2) * kstep; const char* b2 = last ? nB : cB + (size_t)(t + 2) * kstep;
            const char* a3 = a2 + kstep; const char* b3 = b2 + kstep;
            if (last && has_next) S.a_ready(nxt);
            if constexpr (SP2) {
            PG8_LDB(B0, 0, 0); PG8_LDB(B1, 0, 1); PG8_SCHED; PG8_LDA(At, 0, 0); PG8_STAGE(PG8_SA(1, 1), a1 + hstep, voffA);
            PG8_WAIT_V(8); PG8_WAIT_L(0); PG8_BAR; PG8_MMA(0, 0, At, B0); PG8_MMA(0, 1, At, B1); PG8_BAR; PG8_SCHED;
            PG8_LDA(At, 0, 1); PG8_STAGE(PG8_SB(0, 0), b2, voffB); PG8_STAGE(PG8_SB(0, 1), b2 + hstep, voffB); PG8_STAGE(PG8_SA(0, 0), a2, voffA);
            PG8_WAIT_V(8); PG8_WAIT_L(0); PG8_BAR; PG8_MMA(1, 0, At, B0); PG8_MMA(1, 1, At, B1); PG8_BAR; PG8_SCHED;
            PG8_LDB(B0, 1, 0); PG8_LDB(B1, 1, 1); PG8_SCHED; PG8_LDA(At, 1, 0); PG8_STAGE(PG8_SA(0, 1), a2 + hstep, voffA);
            PG8_WAIT_V(8); PG8_WAIT_L(0); PG8_BAR; PG8_MMA(0, 0, At, B0); PG8_MMA(0, 1, At, B1); PG8_BAR; PG8_SCHED;
            PG8_LDA(At, 1, 1); PG8_STAGE(PG8_SB(1, 0), b3, voffB); PG8_STAGE(PG8_SB(1, 1), b3 + hstep, voffB); PG8_STAGE(PG8_SA(1, 0), a3, voffA);
            PG8_WAIT_V(8); PG8_WAIT_L(0); PG8_BAR; PG8_MMA(1, 0, At, B0); PG8_MMA(1, 1, At, B1); PG8_BAR; PG8_SCHED;
            } else {
            PG8_LDB(B0, 0, 0); PG8_SCHED; PG8_LDA(At, 0, 0); PG8_STAGE(PG8_SA(1, 1), a1 + hstep, voffA);
            PG8_WAIT_L(8); PG8_BAR; PG8_WAIT_L(0); PG8_MMA(0, 0, At, B0); PG8_BAR; PG8_SCHED;
            PG8_LDB(B1, 0, 1); PG8_STAGE(PG8_SB(0, 0), b2, voffB);
            PG8_BAR; PG8_WAIT_L(0); PG8_MMA(0, 1, At, B1); PG8_BAR;
            PG8_LDA(At, 0, 1); PG8_STAGE(PG8_SA(0, 0), a2, voffA);
            PG8_BAR; PG8_WAIT_L(0); PG8_MMA(1, 0, At, B0); PG8_BAR; PG8_SCHED;
            PG8_STAGE(PG8_SB(0, 1), b2 + hstep, voffB);
            PG8_WAIT_V(6); PG8_BAR; PG8_MMA(1, 1, At, B1); PG8_BAR;
            PG8_LDB(B0, 1, 0); PG8_SCHED; PG8_LDA(At, 1, 0); PG8_STAGE(PG8_SA(0, 1), a2 + hstep, voffA);
            PG8_WAIT_L(8); PG8_BAR; PG8_WAIT_L(0); PG8_MMA(0, 0, At, B0); PG8_BAR; PG8_SCHED;
            PG8_LDB(B1, 1, 1); PG8_STAGE(PG8_SB(1, 0), b3, voffB);
            PG8_BAR; PG8_WAIT_L(0); PG8_MMA(0, 1, At, B1); PG8_BAR;
            PG8_LDA(At, 1, 1); PG8_STAGE(PG8_SA(1, 0), a3, voffA);
            PG8_BAR; PG8_WAIT_L(0); PG8_MMA(1, 0, At, B0); PG8_BAR; PG8_SCHED;
            PG8_STAGE(PG8_SB(1, 1), b3 + hstep, voffB);
            PG8_WAIT_V(6); PG8_BAR; PG8_MMA(1, 1, At, B1); PG8_BAR;
            }
        }
        if constexpr (ALIGN_EPI) { if (wr == 0) PG8_BAR; }
        if constexpr (!Epi::AFTER_DRAIN) { E(acc, cur, wr, wc, fr, fq); S.done(cur); }
        if (!has_next) break;
#pragma unroll
        for (int a = 0; a < 2; ++a)
#pragma unroll
            for (int b = 0; b < 2; ++b)
#pragma unroll
                for (int m = 0; m < 4; ++m)
#pragma unroll
                    for (int n = 0; n < 2; ++n) acc[a][b][m][n] = (f32x4){0.f, 0.f, 0.f, 0.f};
        cur = nxt; cA = nA; cB = nB; ++ui;
        if constexpr (ALIGN_EPI) { if (wr == 1) PG8_BAR; }
    }
    PG8_WAIT_V(0);
    if constexpr (!ALIGN_EPI) { if (wr == 0) PG8_BAR; }
    PG8_BAR;
    if constexpr (Epi::AFTER_DRAIN) { E.fused(acc, cur, wr, wc, fr, fq, lds, wid, lane); S.done(cur); }
#undef PG8_SA
#undef PG8_SB
#undef PG8_STAGE
#undef PG8_LDA
#undef PG8_LDB
#undef PG8_MMA
#undef PG8_WAIT_V
#undef PG8_WAIT_L
#undef PG8_BAR
#undef PG8_SCHED
}
}

constexpr int NWAVES = 8, NTHR = 512;
constexpr int M = 8704, MP = 8192, D = 2048, DFF = 5632, NUP = 11264, EIN = 6144, OIN = 8192;
constexpr int NPH = 33;
#ifndef MK_PER_PHASE
#define MK_PER_PHASE 1
#endif
constexpr float DN_ALPHA = 1.6817928305074290f;
constexpr float LN_EPS = 1e-5f, NORM_EPS = 1e-6f;
constexpr size_t O_YP = 0, O_YS = O_YP + 16777216, O_RETP = O_YS + 1048576, O_RETS = O_RETP + 2097152, O_RGHP = O_RETS + 67108864, O_RGHS = O_RGHP + 8192,
                 O_RGCP = O_RGHS + 262144, O_RGCS = O_RGCP + 24576, O_HGP = O_RGCS + 786432, O_HGS = O_HGP + 2097152, O_FCP = O_HGS + 67108864, O_FCS = O_FCP + 180224, O_END = O_FCS + 5767168;
constexpr size_t MiB = 1u << 20;
constexpr size_t WS_CTL = 0, CTL_ZERO_BYTES = 1 * MiB;
constexpr size_t WS_ROT = 1 * MiB, WS_RGW = 4 * MiB, WS_WINE = 5 * MiB, WS_WOUTE = 53 * MiB, WS_WINO = 69 * MiB, WS_WOUTO = 133 * MiB, WS_WUP = 149 * MiB, WS_WDOWN = 325 * MiB;
constexpr size_t WS_X = 413 * MiB, WS_XN = 481 * MiB, WS_PB = 515 * MiB, WS_MIX = 651 * MiB, WS_Y = 685 * MiB, WS_UV = 753 * MiB, WS_H = 940 * MiB, WS_END = 1034 * MiB;
constexpr int CW_TMO = 0, CW_CODE = 1, CW_BAR = 4096, CW_Q = 16384;
constexpr int MISC_OFF = 143360, LDS_BYTES = 147456;

#define GAS __attribute__((address_space(1)))
#define LAS __attribute__((address_space(3)))
#define DI __device__ __forceinline__
typedef unsigned short bf16;
typedef unsigned v4u __attribute__((ext_vector_type(4)));
typedef unsigned v2u __attribute__((ext_vector_type(2)));
typedef float f32x4 __attribute__((ext_vector_type(4)));
typedef short bf16x8 __attribute__((ext_vector_type(8)));
typedef short s16x4 __attribute__((ext_vector_type(4)));
typedef short v4i16_t __attribute__((ext_vector_type(4)));
typedef LAS unsigned char* ldsp;
typedef GAS unsigned gu32;
#define RLX_AGENT __ATOMIC_RELAXED, __HIP_MEMORY_SCOPE_AGENT
DI unsigned f2bf(float f) { unsigned u = __builtin_bit_cast(unsigned, f); return (u + 0x7fffu + ((u >> 16) & 1u)) >> 16; }
DI unsigned pk2(float lo, float hi) { return f2bf(lo) | (f2bf(hi) << 16); }
DI float bflo(unsigned w) { return __builtin_bit_cast(float, w << 16); }
DI float bfhi(unsigned w) { return __builtin_bit_cast(float, w & 0xffff0000u); }
DI float bf2f(bf16 v) { return __builtin_bit_cast(float, ((unsigned)v) << 16); }
DI float ex2(float x) { return __builtin_amdgcn_exp2f(x); }
DI float fexp(float x) { return __builtin_amdgcn_exp2f(x * 1.4426950408889634f); }
DI float flog(float x) { return __builtin_amdgcn_logf(x) * 0.6931471805599453f; }
DI float frcp(float x) { return __builtin_amdgcn_rcpf(x); }
DI float sigm(float x) { return frcp(1.0f + fexp(-x)); }
DI float silu(float x) { return x * sigm(x); }
DI float gelu_t(float x) { return x * sigm(1.5957691216057308f * (x + 0.044715f * x * x * x)); }
DI s16x4 tr16(const LAS unsigned char* p) { return __builtin_bit_cast(s16x4, __builtin_amdgcn_ds_read_tr16_b64_v4i16((LAS v4i16_t*)p)); }
DI bf16x8 cat44(s16x4 a, s16x4 b) { bf16x8 r; r[0] = a[0]; r[1] = a[1]; r[2] = a[2]; r[3] = a[3]; r[4] = b[0]; r[5] = b[1]; r[6] = b[2]; r[7] = b[3]; return r; }
DI bf16x8 pack8(f32x4 a, f32x4 b) { v4u w; w.x = pg8::cvt_pk_bf16(a[0], a[1]); w.y = pg8::cvt_pk_bf16(a[2], a[3]); w.z = pg8::cvt_pk_bf16(b[0], b[1]); w.w = pg8::cvt_pk_bf16(b[2], b[3]); return __builtin_bit_cast(bf16x8, w); }
#define MFMA16(a, b, c) __builtin_amdgcn_mfma_f32_16x16x32_bf16((a), (b), (c), 0, 0, 0)
DI float wave_sum(float v) {
#pragma unroll
    for (int o = 1; o < 64; o <<= 1) v += __shfl_xor(v, o);
    return v;
}
#define XB_TMO      128
#define XB_XCNT(j)  (256  + 64 * (j))
#define XB_XSUB(j)  (1280 + 64 * (j))
#define XB_XGEN(j)  (2304 + 64 * (j))
#define XB_TOP      3328
#define XB_TOPGEN   3392
#define XCD_BAR_WORDS 3456
#define XB_SPIN_CAP (1u << 18)

__device__ __forceinline__ unsigned xb_ld(unsigned* p)              { return __hip_atomic_load(p, __ATOMIC_RELAXED, __HIP_MEMORY_SCOPE_AGENT); }
__device__ __forceinline__ unsigned xb_add(unsigned* p, unsigned v) { return __hip_atomic_fetch_add(p, v, __ATOMIC_RELAXED, __HIP_MEMORY_SCOPE_AGENT); }
__device__ __forceinline__ unsigned xb_xcc_id() { return (unsigned)__builtin_amdgcn_s_getreg((3 << 11) | 20) & 0xFu; }
#define XB_SPIN(cond, bar) do { unsigned _sp = 0; while (cond) { __builtin_amdgcn_s_sleep(1); \
    if ((++_sp & 255u) == 0u) { if (xb_ld(&(bar)[XB_TMO])) break; if (_sp > XB_SPIN_CAP) { atomicAdd(&(bar)[XB_TMO], 1u); break; } } } } while (0)

struct XcdBarrier {
    unsigned* bar; unsigned x;
    volatile LAS unsigned* st;
};

__device__ __forceinline__ XcdBarrier xcd_barrier_post(unsigned* bar, volatile LAS unsigned* st) {
    XcdBarrier b; b.bar = bar; b.x = xb_xcc_id(); b.st = st;
    if (threadIdx.x == 0) (void)xb_add(&bar[XB_XCNT(b.x)], 1u);
    return b;
}
__device__ __forceinline__ void xcd_barrier_complete(unsigned* bar, unsigned x, unsigned& nloc, unsigned& nx) {
    const unsigned G = gridDim.x * gridDim.y * gridDim.z;
    unsigned sum, cnt, mine, sp = 0u;
    for (;;) {
        sum = 0u; cnt = 0u; mine = 0u;
#pragma unroll
        for (unsigned j = 0; j < 16; ++j) { const unsigned c = xb_ld(&bar[XB_XCNT(j)]); sum += c; cnt += (c > 0u) ? 1u : 0u; mine = (j == x) ? c : mine; }
        if (sum == G) break;
        __builtin_amdgcn_s_sleep(1);
        if ((++sp & 255u) == 0u) { if (xb_ld(&bar[XB_TMO])) break; if (sp > XB_SPIN_CAP) { atomicAdd(&bar[XB_TMO], 1u); break; } }
    }
    nloc = mine > 0u ? mine : 1u; nx = cnt > 0u ? cnt : 1u;
}

__device__ __forceinline__ void xcd_barrier(const XcdBarrier& b) {
    asm volatile("s_waitcnt vmcnt(0)" ::: "memory");
    __syncthreads();
    if (threadIdx.x == 0) {
        unsigned* bar = b.bar;
        __builtin_amdgcn_s_waitcnt(0);
        unsigned nloc = b.st[0], nx = b.st[1];
        if (nloc == 0u) { xcd_barrier_complete(bar, b.x, nloc, nx); b.st[0] = nloc; b.st[1] = nx; }
        const unsigned old = xb_add(&bar[XB_XSUB(b.x)], 1u);
        const unsigned gen = old / nloc;
        if (old + 1u == (gen + 1u) * nloc) {
            __builtin_amdgcn_fence(__ATOMIC_RELEASE, "agent");
            asm volatile("s_waitcnt vmcnt(0)" ::: "memory");
            const unsigned og = xb_add(&bar[XB_TOP], 1u);
            const unsigned tg = og / nx;
            if (og + 1u == (tg + 1u) * nx) xb_add(&bar[XB_TOPGEN], 1u);
            else XB_SPIN(xb_ld(&bar[XB_TOPGEN]) == tg, bar);
            __builtin_amdgcn_fence(__ATOMIC_ACQUIRE, "agent");
            xb_add(&bar[XB_XGEN(b.x)], 1u);
            asm volatile("s_waitcnt vmcnt(0)" ::: "memory");
        } else {
            XB_SPIN(xb_ld(&bar[XB_XGEN(b.x)]) == gen, bar);
            __builtin_amdgcn_fence(__ATOMIC_ACQUIRE, "agent");
            asm volatile("s_waitcnt vmcnt(0)" ::: "memory");
        }
    }
    __syncthreads();
}

struct Args { const float* in[26]; float* out; unsigned char* ws; int ph_lo, ph_hi; };
struct Frame {
    ldsp lds; volatile LAS unsigned* MISC; gu32* ctl;
    int tid, lane, wave, vcu, G;
    unsigned char* ws; float* out;
};
DI bf16* wsb(const Frame& F, size_t off) { return (bf16*)(F.ws + off); }
DI float* wsf(const Frame& F, size_t off) { return (float*)(F.ws + off); }
DI int q_next(const Frame& F, int qi) {
    __syncthreads();
    if (F.tid == 0) F.MISC[0] = __hip_atomic_fetch_add(F.ctl + CW_Q + 64 * qi, 1u, RLX_AGENT);
    __syncthreads();
    return (int)F.MISC[0];
}

DI void p0_transpose_item(const float* W, int K, int N, bf16* WT, LAS float* scr, int item, int lane) {
    const int nblk = N / 32, kb = item / nblk, nb = item % nblk, k0 = 64 * kb, n0 = 32 * nb;
#pragma unroll 8
    for (int i = 0; i < 32; ++i) { const int kk = 2 * i + (lane >> 5); scr[kk * 33 + (lane & 31)] = W[(size_t)(k0 + kk) * N + n0 + (lane & 31)]; }
    asm volatile("s_waitcnt lgkmcnt(0)" ::: "memory");
    const int c = lane & 7;
#pragma unroll
    for (int j = 0; j < 4; ++j) { const int n = (lane >> 3) + 8 * j; const LAS float* s = scr + (8 * c) * 33 + n;
        v4u o; o.x = pk2(s[0 * 33], s[1 * 33]); o.y = pk2(s[2 * 33], s[3 * 33]); o.z = pk2(s[4 * 33], s[5 * 33]); o.w = pk2(s[6 * 33], s[7 * 33]);
        *(GAS v4u*)(WT + (size_t)(n0 + n) * K + k0 + 8 * c) = o; }
    asm volatile("s_waitcnt lgkmcnt(0)" ::: "memory");
}
DI void xpose_all(const Frame& F, const float* W, int K, int N, bf16* WT, int nmat, LAS float* scr) {
    const int per = (K / 64) * (N / 32), total = per * nmat; const int gw = F.vcu * NWAVES + F.wave, NGW = F.G * NWAVES;
    for (int it = gw; it < total; it += NGW) { const int mt = it / per, r = it - mt * per; p0_transpose_item(W + (size_t)mt * K * N, K, N, WT + (size_t)mt * K * N, scr, r, F.lane); }
}
DI void sincos_d(double x, double& s, double& c) {
    const double x2 = x * x; double ts = 1.0, tc = 1.0;
#pragma unroll
    for (int k = 13; k >= 1; --k) { ts = 1.0 - ts * x2 / (double)((2 * k) * (2 * k + 1)); tc = 1.0 - tc * x2 / (double)((2 * k - 1) * (2 * k)); }
    s = x * ts; c = tc;
}
DI void p0_prologue(const Frame& F, const Args& A) {
    LAS float* scr = (LAS float*)(F.lds + F.wave * 16384);
    xpose_all(F, A.in[7], D, EIN, wsb(F, WS_WINE), 2, scr);
    xpose_all(F, A.in[8], D, D, wsb(F, WS_WOUTE), 2, scr);
    xpose_all(F, A.in[16], D, OIN, wsb(F, WS_WINO), 2, scr);
    xpose_all(F, A.in[17], D, D, wsb(F, WS_WOUTO), 2, scr);
    xpose_all(F, A.in[22], D, NUP, wsb(F, WS_WUP), 4, scr);
    xpose_all(F, A.in[25], DFF, D, wsb(F, WS_WDOWN), 4, scr);
    xpose_all(F, A.in[11], 128, 128, wsb(F, WS_RGW), 16, scr);
    xpose_all(F, A.in[13], 128, 128, wsb(F, WS_RGW) + 16 * 16384, 16, scr);
    const int gt = (F.vcu * NWAVES + F.wave) * 64 + F.lane, NT = F.G * NTHR;
    { const f32x4* xp = (const f32x4*)A.in[0]; const f32x4* xs = (const f32x4*)A.in[1]; f32x4* X = (f32x4*)wsf(F, WS_X); v2u* XN = (v2u*)wsb(F, WS_XN);
      const int np = MP * D / 4, nall = M * D / 4;
      for (int i = gt; i < nall; i += NT) { const f32x4 v = i < np ? xp[i] : xs[i - np]; X[i] = v; v2u w; w.x = pk2(v[0], v[1]); w.y = pk2(v[2], v[3]); XN[i] = w; } }
    { float* rc = wsf(F, WS_ROT); float* rs = rc + 2052 * 128;
      for (int i = gt; i < 2052 * 128; i += NT) { const int pidx = i >> 7, j = i & 127; const int pos = pidx < 2048 ? pidx : 16384 + (pidx - 2048);
          double inv = 1.0, bse = 0.9305720409296989792906463164991290590767; int jj = j;
#pragma unroll
          for (int b = 0; b < 7; ++b) { if (jj & 1) inv *= bse; bse *= bse; jj >>= 1; }
          const double ang = (double)pos * inv; const double n = __builtin_rint(ang * 0.15915494309189533577); const double r = ang - n * 6.283185307179586476925286766559;
          double s, c; sincos_d(r, s, c); rc[i] = (float)c; rs[i] = (float)s; } }
}

DI void ln_phase(const Frame& F, const float* g, const float* bta, float* yout) {
    const int gw = F.vcu * NWAVES + F.wave, NGW = F.G * NWAVES;
    float* X = wsf(F, WS_X); const float* Y = wsf(F, WS_Y); bf16* XN = wsb(F, WS_XN);
    for (int m = gw; m < M; m += NGW) {
        GAS f32x4* xr = (GAS f32x4*)(X + (size_t)m * D) + F.lane; const GAS f32x4* yr = (const GAS f32x4*)(Y + (size_t)m * D) + F.lane;
        f32x4 v[8]; float s = 0.f;
#pragma unroll
        for (int j = 0; j < 8; ++j) { v[j] = xr[64 * j] * DN_ALPHA + yr[64 * j]; s += (v[j][0] + v[j][1]) + (v[j][2] + v[j][3]); }
        const float mean = wave_sum(s) * (1.f / D); float s2 = 0.f;
#pragma unroll
        for (int j = 0; j < 8; ++j) { v[j] = v[j] - mean; s2 += (v[j][0] * v[j][0] + v[j][1] * v[j][1]) + (v[j][2] * v[j][2] + v[j][3] * v[j][3]); }
        const float rstd = 1.f / sqrtf(wave_sum(s2) * (1.f / D) + LN_EPS);
        GAS v2u* o8 = (GAS v2u*)(XN + (size_t)m * D) + F.lane;
#pragma unroll
        for (int j = 0; j < 8; ++j) { const f32x4 gg = ((const f32x4*)g)[F.lane + 64 * j], bb = ((const f32x4*)bta)[F.lane + 64 * j]; const f32x4 o = v[j] * rstd * gg + bb;
            xr[64 * j] = o; v2u w; w.x = pk2(o[0], o[1]); w.y = pk2(o[2], o[3]); o8[64 * j] = w;
            if (yout) ((f32x4*)(yout + (size_t)m * D))[F.lane + 64 * j] = o; }
    }
}
DI void hph_phase(const Frame& F, const Args& A, int l) {
    const int gt = (F.vcu * NWAVES + F.wave) * 64 + F.lane, NT = F.G * NTHR;
    const bf16* UV = wsb(F, WS_UV); bf16* H = wsb(F, WS_H);
    const float* cw = A.in[23] + (size_t)l * 3 * DFF; const float* cb = A.in[24] + (size_t)l * DFF; const float* sbuf = A.in[6] + (size_t)l * 128 * 2 * DFF;
    float* fcp = F.out + O_FCP + (size_t)l * 4 * 2 * DFF; float* fcs = F.out + O_FCS + (size_t)l * 128 * 2 * DFF;
    constexpr int NCH = DFF / 8;
    for (int it = gt; it < M * NCH; it += NT) {
        const int r = it / NCH, ch = it - r * NCH, c0 = ch * 8;
        const v4u u0 = *(const v4u*)(UV + (size_t)r * NUP + c0), vv = *(const v4u*)(UV + (size_t)r * NUP + DFF + c0);
        float um1[8], um2[8], uc[8];
        uc[0] = bflo(u0.x); uc[1] = bfhi(u0.x); uc[2] = bflo(u0.y); uc[3] = bfhi(u0.y); uc[4] = bflo(u0.z); uc[5] = bfhi(u0.z); uc[6] = bflo(u0.w); uc[7] = bfhi(u0.w);
        int t, T; const float* b0 = nullptr;
        if (r < MP) { t = r & 2047; T = 2048; } else { t = r & 3; T = 4; b0 = sbuf + (size_t)((r - MP) >> 2) * 2 * DFF + c0; }
#pragma unroll
        for (int k = 0; k < 8; ++k) { um1[k] = 0.f; um2[k] = 0.f; }
        if (t >= 1) { const v4u w = *(const v4u*)(UV + (size_t)(r - 1) * NUP + c0); um1[0] = bflo(w.x); um1[1] = bfhi(w.x); um1[2] = bflo(w.y); um1[3] = bfhi(w.y); um1[4] = bflo(w.z); um1[5] = bfhi(w.z); um1[6] = bflo(w.w); um1[7] = bfhi(w.w); }
        else if (b0) {
#pragma unroll
            for (int k = 0; k < 8; ++k) um1[k] = b0[DFF + k]; }
        if (t >= 2) { const v4u w = *(const v4u*)(UV + (size_t)(r - 2) * NUP + c0); um2[0] = bflo(w.x); um2[1] = bfhi(w.x); um2[2] = bflo(w.y); um2[3] = bfhi(w.y); um2[4] = bflo(w.z); um2[5] = bfhi(w.z); um2[6] = bflo(w.w); um2[7] = bfhi(w.w); }
        else if (b0) {
#pragma unroll
            for (int k = 0; k < 8; ++k) um2[k] = b0[(t == 1 ? DFF : 0) + k]; }
        float vf[8]; vf[0] = bflo(vv.x); vf[1] = bfhi(vv.x); vf[2] = bflo(vv.y); vf[3] = bfhi(vv.y); vf[4] = bflo(vv.z); vf[5] = bfhi(vv.z); vf[6] = bflo(vv.w); vf[7] = bfhi(vv.w);
        float h[8];
#pragma unroll
        for (int k = 0; k < 8; ++k) { const float y = cw[c0 + k] * um2[k] + cw[DFF + c0 + k] * um1[k] + cw[2 * DFF + c0 + k] * uc[k] + cb[c0 + k]; h[k] = gelu_t(y) * vf[k]; }
        v4u o; o.x = pk2(h[0], h[1]); o.y = pk2(h[2], h[3]); o.z = pk2(h[4], h[5]); o.w = pk2(h[6], h[7]);
        *(v4u*)(H + (size_t)r * DFF + c0) = o;
        if (t >= T - 2) { float* dst = (r < MP) ? fcp + ((size_t)(r >> 11) * 2 + (t - (T - 2))) * DFF + c0 : fcs + ((size_t)((r - MP) >> 2) * 2 + (t - (T - 2))) * DFF + c0;
            *(f32x4*)dst = (f32x4){uc[0], uc[1], uc[2], uc[3]}; *(f32x4*)(dst + 4) = (f32x4){uc[4], uc[5], uc[6], uc[7]}; }
    }
}

constexpr int LST256 = 544, LST128 = 288, LST64 = 160;

DI void ret_flash(const Frame& F, int b, int h, int qb) {
    int tid_ = F.tid; asm volatile("" : "+v"(tid_));
    const int tid = tid_, lane = tid & 63, w = __builtin_amdgcn_readfirstlane(tid >> 6), tb = w >> 1, vh = w & 1, c = lane & 15, kq = lane >> 4;
    ldsp Ks = F.lds, Vs = F.lds + 64 * LST256; LAS float* red = (LAS float*)(F.lds + 2 * 64 * LST256);
    const bf16* Pb = wsb(F, WS_PB) + (size_t)(b * 2048) * EIN; bf16* MX = wsb(F, WS_MIX) + (size_t)(b * 2048) * D;
    const int t0 = qb * 64;
    bf16x8 qf[8];
    { const bf16* qp = Pb + (size_t)(t0 + 16 * tb + c) * EIN + h * 256 + 8 * kq;
#pragma unroll
      for (int ks = 0; ks < 8; ++ks) qf[ks] = *(const bf16x8*)(qp + 32 * ks); }
    f32x4 o[8];
#pragma unroll
    for (int i = 0; i < 8; ++i) o[i] = (f32x4){0.f, 0.f, 0.f, 0.f};
    const float l2g = __builtin_amdgcn_logf(1.0f - ex2(-5.0f - (float)h));
    const int sr = tid >> 3, sc = tid & 7;
    v4u kreg[4], vreg[4];
#define RET_LOADKV(j) do { const bf16* kp_ = Pb + (size_t)(64 * (j) + sr) * EIN + 1024 + h * 256 + 8 * sc; \
        _Pragma("unroll") for (int i_ = 0; i_ < 4; ++i_) { kreg[i_] = *(const v4u*)(kp_ + 64 * i_); vreg[i_] = *(const v4u*)(kp_ + 1024 + 64 * i_); } } while (0)
    RET_LOADKV(0);
    const int tq = t0 + 16 * tb + c;
    for (int j = 0; j <= qb; ++j) {
        __syncthreads();
#pragma unroll
        for (int i = 0; i < 4; ++i) { *(LAS v4u*)(Ks + sr * LST256 + (sc + 8 * i) * 16) = kreg[i]; *(LAS v4u*)(Vs + sr * LST256 + (sc + 8 * i) * 16) = vreg[i]; }
        __syncthreads();
        if (j < qb) RET_LOADKV(j + 1);
        f32x4 pt[4];
#pragma unroll
        for (int a = 0; a < 4; ++a) { pt[a] = (f32x4){0.f, 0.f, 0.f, 0.f};
#pragma unroll
            for (int ks = 0; ks < 8; ++ks) { const bf16x8 kf = *(const LAS bf16x8*)(Ks + (16 * a + c) * LST256 + (32 * ks + 8 * kq) * 2); pt[a] = MFMA16(kf, qf[ks], pt[a]); } }
#pragma unroll
        for (int a = 0; a < 4; ++a)
#pragma unroll
            for (int i = 0; i < 4; ++i) { const int dd = tq - (64 * j + 16 * a + 4 * kq + i); pt[a][i] = dd >= 0 ? pt[a][i] * ex2((float)dd * l2g) : 0.f; }
#pragma unroll
        for (int pr = 0; pr < 2; ++pr) { const bf16x8 pa = pack8(pt[2 * pr], pt[2 * pr + 1]);
            const LAS unsigned char* vb = Vs + (32 * pr + 4 * kq + (c >> 2)) * LST256 + (128 * vh + 4 * (c & 3)) * 2;
#pragma unroll
            for (int vt = 0; vt < 8; ++vt) { const bf16x8 bfr = cat44(tr16(vb + vt * 32), tr16(vb + vt * 32 + 16 * LST256)); o[vt] = MFMA16(pa, bfr, o[vt]); } }
    }
#undef RET_LOADKV
    float ss[4];
#pragma unroll
    for (int i = 0; i < 4; ++i) { float s = 0.f;
#pragma unroll
        for (int vt = 0; vt < 8; ++vt) s += o[vt][i] * o[vt][i];
        s += __shfl_xor(s, 1); s += __shfl_xor(s, 2); s += __shfl_xor(s, 4); s += __shfl_xor(s, 8); ss[i] = s; }
    if (c == 0) {
#pragma unroll
        for (int i = 0; i < 4; ++i) red[(tb * 2 + vh) * 16 + 4 * kq + i] = ss[i]; }
    __syncthreads();
#pragma unroll
    for (int i = 0; i < 4; ++i) { const float tot = red[(tb * 2) * 16 + 4 * kq + i] + red[(tb * 2 + 1) * 16 + 4 * kq + i]; const float rstd = __builtin_amdgcn_rsqf(tot * (1.f / 256.f) + NORM_EPS);
        const int row = t0 + 16 * tb + 4 * kq + i;
#pragma unroll
        for (int vt = 0; vt < 8; ++vt) { const int col = h * 256 + 128 * vh + 16 * vt + c; const float gv = bf2f(Pb[(size_t)row * EIN + 3072 + col]);
            MX[(size_t)row * D + col] = (bf16)f2bf(o[vt][i] * rstd * silu(gv)); } }
}

DI void ret_state(const Frame& F, int e, int u) {
    int tid_ = F.tid; asm volatile("" : "+v"(tid_));
    const int tid = tid_, lane = tid & 63, w = __builtin_amdgcn_readfirstlane(tid >> 6), c = lane & 15, kq = lane >> 4;
    const int b = u >> 4, h = (u >> 2) & 3, vq = u & 3;
    ldsp Ks = F.lds, Vs = F.lds + 64 * LST256;
    const bf16* Pb = wsb(F, WS_PB) + (size_t)(b * 2048) * EIN;
    const float gam = 1.0f - ex2(-5.0f - (float)h), l2g = __builtin_amdgcn_logf(gam), cdec = ex2(64.f * l2g);
    f32x4 S[2][4];
#pragma unroll
    for (int a = 0; a < 2; ++a)
#pragma unroll
        for (int v = 0; v < 4; ++v) S[a][v] = (f32x4){0.f, 0.f, 0.f, 0.f};
    const int sr = tid >> 3, sc = tid & 7; const float zeta = ex2((float)(63 - sr) * l2g);
    for (int j = 0; j < 32; ++j) {
        const bf16* kp = Pb + (size_t)(64 * j + sr) * EIN + 1024 + h * 256 + 8 * sc;
        v4u kreg[4];
#pragma unroll
        for (int i = 0; i < 4; ++i) kreg[i] = *(const v4u*)(kp + 64 * i);
        const v4u vr = *(const v4u*)(Pb + (size_t)(64 * j + sr) * EIN + 2048 + h * 256 + 64 * vq + 8 * sc);
        __syncthreads();
#pragma unroll
        for (int i = 0; i < 4; ++i) *(LAS v4u*)(Ks + sr * LST256 + (sc + 8 * i) * 16) = kreg[i];
        { v4u z; z.x = pk2(bflo(vr.x) * zeta, bfhi(vr.x) * zeta); z.y = pk2(bflo(vr.y) * zeta, bfhi(vr.y) * zeta); z.z = pk2(bflo(vr.z) * zeta, bfhi(vr.z) * zeta); z.w = pk2(bflo(vr.w) * zeta, bfhi(vr.w) * zeta);
          *(LAS v4u*)(Vs + sr * LST64 + sc * 16) = z; }
        __syncthreads();
#pragma unroll
        for (int a = 0; a < 2; ++a)
#pragma unroll
            for (int v = 0; v < 4; ++v) S[a][v] = S[a][v] * cdec;
#pragma unroll
        for (int ks = 0; ks < 2; ++ks) {
            bf16x8 af[2], bfr[4];
#pragma unroll
            for (int a = 0; a < 2; ++a) { const LAS unsigned char* p = Ks + (32 * ks + 8 * kq + (c >> 2)) * LST256 + (16 * (2 * w + a) + 4 * (c & 3)) * 2; af[a] = cat44(tr16(p), tr16(p + 4 * LST256)); }
#pragma unroll
            for (int v = 0; v < 4; ++v) { const LAS unsigned char* p = Vs + (32 * ks + 8 * kq + (c >> 2)) * LST64 + (16 * v + 4 * (c & 3)) * 2; bfr[v] = cat44(tr16(p), tr16(p + 4 * LST64)); }
#pragma unroll
            for (int a = 0; a < 2; ++a)
#pragma unroll
                for (int v = 0; v < 4; ++v) S[a][v] = MFMA16(af[a], bfr[v], S[a][v]);
        }
    }
    float* dst = F.out + O_RETP + ((size_t)((e * 4 + b) * 4 + h)) * 65536;
#pragma unroll
    for (int a = 0; a < 2; ++a)
#pragma unroll
        for (int v = 0; v < 4; ++v)
#pragma unroll
            for (int i = 0; i < 4; ++i) dst[(size_t)(16 * (2 * w + a) + 4 * kq + i) * 256 + 64 * vq + 16 * v + c] = S[a][v][i];
}

DI void ret_sample(const Frame& F, const Args& A, int e, int u) {
    int tid_ = F.tid; asm volatile("" : "+v"(tid_));
    const int tid = tid_, lane = tid & 63, w = __builtin_amdgcn_readfirstlane(tid >> 6);
    const int b = u >> 2, h = u & 3;
    LAS float* qf = (LAS float*)F.lds;
    LAS float* kf = qf + 1024; LAS float* vf = kf + 1024; LAS float* part = vf + 1024;
    LAS float* inner = part + 2048;
    LAS float* red = inner + 16;
    const bf16* Pr = wsb(F, WS_PB) + (size_t)(MP + 4 * b) * EIN; bf16* MX = wsb(F, WS_MIX) + (size_t)(MP + 4 * b) * D;
    const float gam = 1.0f - ex2(-5.0f - (float)h), l2g = __builtin_amdgcn_logf(gam);
    __syncthreads();
#pragma unroll
    for (int i = 0; i < 2; ++i) { const int idx = tid + 512 * i, t = idx >> 8, cc = idx & 255; const bf16* pr = Pr + (size_t)t * EIN + h * 256 + cc;
        qf[idx] = bf2f(pr[0]); kf[idx] = bf2f(pr[1024]); vf[idx] = bf2f(pr[2048]); }
    __syncthreads();
#pragma unroll
    for (int i = 0; i < 2; ++i) { const int p = 2 * w + i, t = p >> 2, s = p & 3; float acc = 0.f;
#pragma unroll
        for (int k = 0; k < 4; ++k) acc += qf[t * 256 + lane + 64 * k] * kf[s * 256 + lane + 64 * k];
        acc = wave_sum(acc); if (lane == 0) inner[p] = t >= s ? acc * ex2((float)(t - s) * l2g) : 0.f; }
    const int v = tid & 255, kh = tid >> 8;
    const float* S0 = A.in[2] + ((size_t)((e * 128 + b) * 4 + h)) * 65536 + (size_t)(128 * kh) * 256 + v;
    float* Sn = F.out + O_RETS + ((size_t)((e * 128 + b) * 4 + h)) * 65536 + (size_t)(128 * kh) * 256 + v;
    const float cdec = ex2(4.f * l2g);
    float vz[4], acc[4];
#pragma unroll
    for (int s = 0; s < 4; ++s) { vz[s] = vf[s * 256 + v] * ex2((float)(3 - s) * l2g); acc[s] = 0.f; }
    for (int k0 = 0; k0 < 128; k0 += 8) {
        float s0[8];
#pragma unroll
        for (int i = 0; i < 8; ++i) s0[i] = __builtin_nontemporal_load(S0 + (size_t)(k0 + i) * 256);
#pragma unroll
        for (int i = 0; i < 8; ++i) { const int k = 128 * kh + k0 + i; float sn = cdec * s0[i];
#pragma unroll
            for (int t = 0; t < 4; ++t) { acc[t] += qf[t * 256 + k] * s0[i]; sn += kf[t * 256 + k] * vz[t]; }
            __builtin_nontemporal_store(sn, Sn + (size_t)(k0 + i) * 256); }
    }
#pragma unroll
    for (int t = 0; t < 4; ++t) part[(kh * 4 + t) * 256 + v] = acc[t];
    __syncthreads();
    if (tid < 256) {
        float o[4], ssq[4];
#pragma unroll
        for (int t = 0; t < 4; ++t) { float x = ex2((float)(t + 1) * l2g) * (part[t * 256 + v] + part[(4 + t) * 256 + v]);
#pragma unroll
            for (int s = 0; s < 4; ++s) x += inner[t * 4 + s] * vf[s * 256 + v];
            o[t] = x; ssq[t] = wave_sum(x * x); }
        if (lane == 0) {
#pragma unroll
            for (int t = 0; t < 4; ++t) red[w * 4 + t] = ssq[t]; }
    }
    __syncthreads();
    if (tid < 256) {
#pragma unroll
        for (int t = 0; t < 4; ++t) { const float tot = red[t] + red[4 + t] + red[8 + t] + red[12 + t]; const float rstd = __builtin_amdgcn_rsqf(tot * (1.f / 256.f) + NORM_EPS);
            float x = ex2((float)(t + 1) * l2g) * (part[t * 256 + v] + part[(4 + t) * 256 + v]);
#pragma unroll
            for (int s = 0; s < 4; ++s) x += inner[t * 4 + s] * vf[s * 256 + v];
            const float gv = bf2f(Pr[(size_t)t * EIN + 3072 + h * 256 + v]);
            MX[(size_t)t * D + h * 256 + v] = (bf16)f2bf(x * rstd * silu(gv)); }
    }
}

template <bool SAMPLE> DI void rglru_unit(const Frame& F, const Args& A, int e, int u) {
    int tid_ = F.tid; asm volatile("" : "+v"(tid_));
    const int tid = tid_, lane = tid & 63, w = __builtin_amdgcn_readfirstlane(tid >> 6), c = lane & 15, kq = lane >> 4;
    const int sq = u >> 5, blk = (u >> 2) & 7, qt = u & 3;
    ldsp XC = F.lds;
    LAS float* XCF = (LAS float*)(F.lds + 128 * LST128);
    LAS float* AA = XCF + 4096; LAS float* BB = AA + 4096;
    LAS float* SEGA = BB + 4096; LAS float* SEGB = SEGA + 512;
    LAS float* HC = SEGB + 512;
    const int chb = blk * 128;
    const bf16* Pb = wsb(F, WS_PB); bf16* MX = wsb(F, WS_MIX);
    const size_t row_base = SAMPLE ? (size_t)(MP + 128 * sq) : (size_t)sq * 2048;
    bf16x8 waf[2][4], wxf[2][4];
    { const bf16* wa = wsb(F, WS_RGW) + (size_t)((e * 8 + blk) * 128 + qt * 32 + c) * 128 + 8 * kq; const bf16* wx = wa + 16 * 16384;
#pragma unroll
      for (int jt = 0; jt < 2; ++jt)
#pragma unroll
          for (int ks = 0; ks < 4; ++ks) { waf[jt][ks] = *(const bf16x8*)(wa + jt * 16 * 128 + 32 * ks); wxf[jt][ks] = *(const bf16x8*)(wx + jt * 16 * 128 + 32 * ks); } }
    float bav[2], bxv[2], la0[2];
#pragma unroll
    for (int jt = 0; jt < 2; ++jt) { const int ch = e * 1024 + chb + qt * 32 + 16 * jt + c; bav[jt] = A.in[12][ch]; bxv[jt] = A.in[14][ch];
        const float x = fexp(-A.in[15][ch]); const float sp = x < 0.03f ? x * (1.f - x * (0.5f - x * (0.33333333f - 0.25f * x))) : flog(1.f + x); la0[jt] = -8.0f * sp; }
    const int cg = tid & 15, rg = tid >> 4;
    float cwv[4][8], cbv[8];
    { const float* cw = A.in[9] + (size_t)e * 4 * 1024 + chb + 8 * cg; const float* cb = A.in[10] + (size_t)e * 1024 + chb + 8 * cg;
#pragma unroll
      for (int k = 0; k < 8; ++k) { cbv[k] = cb[k];
#pragma unroll
          for (int j = 0; j < 4; ++j) cwv[j][k] = cw[j * 1024 + k]; } }
    const int sj = tid & 31, sseg = tid >> 5;
    const int sch = chb + qt * 32 + sj;
    __syncthreads();
    if (tid < 64) HC[tid] = 0.f;
    const int ntile = SAMPLE ? 1 : 16;
    float hlast = 0.f;
    for (int tile = 0; tile < ntile; ++tile) {
        const int t0 = 128 * tile;
        {
            float xin[7][8];
            const bf16* xr = Pb + (row_base + t0 + 4 * rg) * EIN + 4096 + chb + 8 * cg;
#pragma unroll
            for (int r7 = 0; r7 < 7; ++r7) {
                if (SAMPLE) {
                    if (r7 < 3) { const float* bp = A.in[4] + ((size_t)((e * 128 + 32 * sq + rg) * 3 + r7)) * 1024 + chb + 8 * cg;
#pragma unroll
                        for (int k = 0; k < 8; ++k) xin[r7][k] = bp[k]; }
                    else { const v4u wv = *(const v4u*)(xr + (size_t)(r7 - 3) * EIN);
                        xin[r7][0] = bflo(wv.x); xin[r7][1] = bfhi(wv.x); xin[r7][2] = bflo(wv.y); xin[r7][3] = bfhi(wv.y); xin[r7][4] = bflo(wv.z); xin[r7][5] = bfhi(wv.z); xin[r7][6] = bflo(wv.w); xin[r7][7] = bfhi(wv.w); }
                } else {
                    const int tt = t0 + 4 * rg + r7 - 3;
                    if (tt >= 0) { const v4u wv = *(const v4u*)(xr + (ptrdiff_t)(r7 - 3) * EIN);
                        xin[r7][0] = bflo(wv.x); xin[r7][1] = bfhi(wv.x); xin[r7][2] = bflo(wv.y); xin[r7][3] = bfhi(wv.y); xin[r7][4] = bflo(wv.z); xin[r7][5] = bfhi(wv.z); xin[r7][6] = bflo(wv.w); xin[r7][7] = bfhi(wv.w); }
                    else {
#pragma unroll
                        for (int k = 0; k < 8; ++k) xin[r7][k] = 0.f; }
                }
            }
#pragma unroll
            for (int rr = 0; rr < 4; ++rr) { float xc[8];
#pragma unroll
                for (int k = 0; k < 8; ++k) xc[k] = cbv[k] + cwv[0][k] * xin[rr][k] + cwv[1][k] * xin[rr + 1][k] + cwv[2][k] * xin[rr + 2][k] + cwv[3][k] * xin[rr + 3][k];
                v4u o; o.x = pk2(xc[0], xc[1]); o.y = pk2(xc[2], xc[3]); o.z = pk2(xc[4], xc[5]); o.w = pk2(xc[6], xc[7]);
                *(LAS v4u*)(XC + (4 * rg + rr) * LST128 + cg * 16) = o;
                if ((cg >> 2) == qt) {
#pragma unroll
                    for (int k = 0; k < 8; ++k) XCF[(4 * rg + rr) * 32 + 8 * (cg & 3) + k] = xc[k]; } }
            if ((cg >> 2) == qt) {
                if (SAMPLE) { float* dst = F.out + O_RGCS + ((size_t)(e * 128 + 32 * sq + rg) * 3) * 1024 + chb + 8 * cg;
#pragma unroll
                    for (int r3 = 0; r3 < 3; ++r3)
#pragma unroll
                        for (int k = 0; k < 8; ++k) dst[r3 * 1024 + k] = xin[4 + r3][k]; }
                else if (tile == 15 && rg == 31) { float* dst = F.out + O_RGCP + ((size_t)(e * 4 + sq) * 3) * 1024 + chb + 8 * cg;
#pragma unroll
                    for (int r3 = 0; r3 < 3; ++r3)
#pragma unroll
                        for (int k = 0; k < 8; ++k) dst[r3 * 1024 + k] = xin[4 + r3][k]; }
            }
        }
        __syncthreads();
        {
            f32x4 ga[2], gx[2];
#pragma unroll
            for (int jt = 0; jt < 2; ++jt) { ga[jt] = (f32x4){0.f, 0.f, 0.f, 0.f}; gx[jt] = (f32x4){0.f, 0.f, 0.f, 0.f}; }
#pragma unroll
            for (int ks = 0; ks < 4; ++ks) { const bf16x8 af = *(const LAS bf16x8*)(XC + (16 * w + c) * LST128 + (32 * ks + 8 * kq) * 2);
#pragma unroll
                for (int jt = 0; jt < 2; ++jt) { ga[jt] = MFMA16(af, waf[jt][ks], ga[jt]); gx[jt] = MFMA16(af, wxf[jt][ks], gx[jt]); } }
#pragma unroll
            for (int jt = 0; jt < 2; ++jt)
#pragma unroll
                for (int i = 0; i < 4; ++i) { const int rl = 16 * w + 4 * kq + i, j = 16 * jt + c;
                    const float r = sigm(ga[jt][i] + bav[jt]), ig = sigm(gx[jt][i] + bxv[jt]); const float la = la0[jt] * r, y = 2.f * la;
                    float mult = sqrtf(-y * (1.f + y * (0.5f + y * (0.16666667f + y * (0.041666667f + y * 0.0083333333f)))));
                    if (!SAMPLE && (t0 + rl) == 0) mult = 1.f;
                    AA[rl * 32 + j] = fexp(la); BB[rl * 32 + j] = XCF[rl * 32 + j] * ig * mult; }
        }
        __syncthreads();
        if (SAMPLE) {
#pragma unroll
            for (int it = 0; it < 2; ++it) { const int bl = sseg + 16 * it, bglob = 32 * sq + bl; float hh = A.in[3][(size_t)(e * 128 + bglob) * 1024 + sch];
#pragma unroll
                for (int t = 0; t < 4; ++t) { const int rl = 4 * bl + t; hh = AA[rl * 32 + sj] * hh + BB[rl * 32 + sj];
                    const size_t row = row_base + rl; const float gr = bf2f(Pb[row * EIN + 5120 + sch]); MX[row * D + 1024 + sch] = (bf16)f2bf(hh * gelu_t(gr)); }
                F.out[O_RGHS + (size_t)(e * 128 + bglob) * 1024 + sch] = hh; }
        } else {
            float av[8], bv[8]; float pa = 1.f, pb = 0.f;
#pragma unroll
            for (int rr = 0; rr < 8; ++rr) { av[rr] = AA[(8 * sseg + rr) * 32 + sj]; bv[rr] = BB[(8 * sseg + rr) * 32 + sj]; pb = av[rr] * pb + bv[rr]; pa *= av[rr]; }
            SEGA[sseg * 32 + sj] = pa; SEGB[sseg * 32 + sj] = pb;
            __syncthreads();
            float hh = HC[(tile & 1) * 32 + sj];
            for (int s2 = 0; s2 < sseg; ++s2) hh = SEGA[s2 * 32 + sj] * hh + SEGB[s2 * 32 + sj];
#pragma unroll
            for (int rr = 0; rr < 8; ++rr) { hh = av[rr] * hh + bv[rr]; const size_t row = row_base + t0 + 8 * sseg + rr;
                const float gr = bf2f(Pb[row * EIN + 5120 + sch]); MX[row * D + 1024 + sch] = (bf16)f2bf(hh * gelu_t(gr)); }
            if (sseg == 15) { HC[((tile + 1) & 1) * 32 + sj] = hh; hlast = hh; }
        }
        __syncthreads();
    }
    if (!SAMPLE && sseg == 15) F.out[O_RGHP + (size_t)(e * 4 + sq) * 1024 + sch] = hlast;
}

DI float hg_lb(const Args& A, int o, int col) { if (o == 0) return 0.f; return sigm(A.in[19][2048 + col] - A.in[19][col]); }

DI void gla_prompt(const Frame& F, const Args& A, int o, int u) {
    int tid_ = F.tid; asm volatile("" : "+v"(tid_));
    const int tid = tid_, lane = tid & 63, w = __builtin_amdgcn_readfirstlane(tid >> 6), tb = w >> 1, vh = w & 1, c = lane & 15, kq = lane >> 4;
    const int b = u >> 4, h = u & 15;
    constexpr int TB = 64 * LST128;
    ldsp QP = F.lds, KP = F.lds + TB, QS = F.lds + 2 * TB, KL = F.lds + 3 * TB, VS = F.lds + 4 * TB, ST = F.lds + 5 * TB;
    LAS float* SEGT = (LAS float*)(F.lds + 5 * TB + 128 * LST128);
    LAS float* EB = SEGT + 512;
    LAS float* red = EB + 128;
    const bf16* Pb = wsb(F, WS_PB) + (size_t)(b * 2048) * OIN; bf16* MX = wsb(F, WS_MIX) + (size_t)(b * 2048) * D;
    const int ek = tid & 127, eseg = tid >> 7;
    const float lbv = hg_lb(A, o, h * 128 + ek);
    f32x4 S[8];
#pragma unroll
    for (int v = 0; v < 8; ++v) S[v] = (f32x4){0.f, 0.f, 0.f, 0.f};
    __syncthreads();
    for (int i = tid; i < 128 * LST128 / 4; i += NTHR) ((LAS unsigned*)ST)[i] = 0u;
    float ngv[4];
#pragma unroll
    for (int vt = 0; vt < 4; ++vt) ngv[vt] = A.in[18][o * 128 + 64 * vh + 16 * vt + c];
    const int sr = tid >> 3, sc = tid & 7;
    for (int n = 0; n < 32; ++n) {
        const int t0 = 64 * n;
        float bl[16], kk[16], qs[16]; float cum = 0.f;
        { const bf16* pq = Pb + (size_t)(t0 + 16 * eseg) * OIN + h * 128 + ek;
#pragma unroll
          for (int rr = 0; rr < 16; ++rr) { const float qv = bf2f(pq[(size_t)rr * OIN]), fv = bf2f(pq[(size_t)rr * OIN + 2048]);
              const float fg = lbv + (1.f - lbv) * sigm(fv); cum += flog(fg); bl[rr] = cum; kk[rr] = 1.f - fg; qs[rr] = silu(qv); } }
        const v4u vr0 = *(const v4u*)(Pb + (size_t)(t0 + sr) * OIN + 4096 + h * 128 + 8 * sc), vr1 = *(const v4u*)(Pb + (size_t)(t0 + sr) * OIN + 4096 + h * 128 + 64 + 8 * sc);
        SEGT[eseg * 128 + ek] = cum;
        __syncthreads();
        { const float s0 = SEGT[ek], s1 = SEGT[128 + ek], s2 = SEGT[256 + ek], s3 = SEGT[384 + ek];
          const float pre = eseg == 0 ? 0.f : (eseg == 1 ? s0 : (eseg == 2 ? s0 + s1 : s0 + s1 + s2));
          const float bref = s0 + s1, blast = bref + s2 + s3; const float eref = fexp(bref), elast = fexp(blast - bref);
          if (eseg == 0) EB[ek] = fexp(blast);
#pragma unroll
          for (int rr = 0; rr < 16; ++rr) { const float bt = pre + bl[rr]; const float e1 = fexp(bt - bref), e2 = fexp(bref - bt); const float q1 = qs[rr] * e1, k1 = kk[rr] * e2;
              const int off = (16 * eseg + rr) * LST128 + ek * 2;
              *(LAS bf16*)(QP + off) = (bf16)f2bf(q1); *(LAS bf16*)(KP + off) = (bf16)f2bf(k1); *(LAS bf16*)(QS + off) = (bf16)f2bf(q1 * eref); *(LAS bf16*)(KL + off) = (bf16)f2bf(k1 * elast); } }
        *(LAS v4u*)(VS + sr * LST128 + sc * 16) = vr0; *(LAS v4u*)(VS + sr * LST128 + 128 + sc * 16) = vr1;
        __syncthreads();
        f32x4 ov[4];
#pragma unroll
        for (int vt = 0; vt < 4; ++vt) ov[vt] = (f32x4){0.f, 0.f, 0.f, 0.f};
        {
            bf16x8 qf[4];
#pragma unroll
            for (int ks = 0; ks < 4; ++ks) qf[ks] = *(const LAS bf16x8*)(QP + (16 * tb + c) * LST128 + (32 * ks + 8 * kq) * 2);
            f32x4 pt[4];
#pragma unroll
            for (int a = 0; a < 4; ++a) { pt[a] = (f32x4){0.f, 0.f, 0.f, 0.f};
#pragma unroll
                for (int ks = 0; ks < 4; ++ks) { const bf16x8 kf = *(const LAS bf16x8*)(KP + (16 * a + c) * LST128 + (32 * ks + 8 * kq) * 2); pt[a] = MFMA16(kf, qf[ks], pt[a]); }
#pragma unroll
                for (int i = 0; i < 4; ++i) pt[a][i] = (16 * a + 4 * kq + i) <= (16 * tb + c) ? pt[a][i] : 0.f; }
#pragma unroll
            for (int pr = 0; pr < 2; ++pr) { const bf16x8 pa = pack8(pt[2 * pr], pt[2 * pr + 1]);
                const LAS unsigned char* vb = VS + (32 * pr + 4 * kq + (c >> 2)) * LST128 + (64 * vh + 4 * (c & 3)) * 2;
#pragma unroll
                for (int vt = 0; vt < 4; ++vt) { const bf16x8 bfr = cat44(tr16(vb + vt * 32), tr16(vb + vt * 32 + 16 * LST128)); ov[vt] = MFMA16(pa, bfr, ov[vt]); } }
#pragma unroll
            for (int ks = 0; ks < 4; ++ks) { const bf16x8 af = *(const LAS bf16x8*)(QS + (16 * tb + c) * LST128 + (32 * ks + 8 * kq) * 2);
#pragma unroll
                for (int vt = 0; vt < 4; ++vt) { const bf16x8 bfr = *(const LAS bf16x8*)(ST + (64 * vh + 16 * vt + c) * LST128 + (32 * ks + 8 * kq) * 2); ov[vt] = MFMA16(af, bfr, ov[vt]); } }
        }
        float ss[4];
#pragma unroll
        for (int i = 0; i < 4; ++i) { float s = 0.f;
#pragma unroll
            for (int vt = 0; vt < 4; ++vt) s += ov[vt][i] * ov[vt][i];
            s += __shfl_xor(s, 1); s += __shfl_xor(s, 2); s += __shfl_xor(s, 4); s += __shfl_xor(s, 8); ss[i] = s; }
        if (c == 0) {
#pragma unroll
            for (int i = 0; i < 4; ++i) red[(tb * 2 + vh) * 16 + 4 * kq + i] = ss[i]; }
        __syncthreads();
#pragma unroll
        for (int i = 0; i < 4; ++i) { const float tot = red[(tb * 2) * 16 + 4 * kq + i] + red[(tb * 2 + 1) * 16 + 4 * kq + i]; const float rstd = __builtin_amdgcn_rsqf(tot * (1.f / 128.f) + NORM_EPS);
            const int row = t0 + 16 * tb + 4 * kq + i;
#pragma unroll
            for (int vt = 0; vt < 4; ++vt) { const int col = h * 128 + 64 * vh + 16 * vt + c; const float gv = bf2f(Pb[(size_t)row * OIN + 6144 + col]);
                MX[(size_t)row * D + col] = (bf16)f2bf(ov[vt][i] * rstd * ngv[vt] * sigm(gv)); } }
        {
            f32x4 eb;
#pragma unroll
            for (int i = 0; i < 4; ++i) eb[i] = EB[16 * w + 4 * kq + i];
#pragma unroll
            for (int v = 0; v < 8; ++v) S[v] = S[v] * eb;
#pragma unroll
            for (int ks = 0; ks < 2; ++ks) { const LAS unsigned char* pk = KL + (32 * ks + 8 * kq + (c >> 2)) * LST128 + (16 * w + 4 * (c & 3)) * 2; const bf16x8 af = cat44(tr16(pk), tr16(pk + 4 * LST128));
                const LAS unsigned char* pv = VS + (32 * ks + 8 * kq + (c >> 2)) * LST128 + (4 * (c & 3)) * 2;
#pragma unroll
                for (int v = 0; v < 8; ++v) { const bf16x8 bfr = cat44(tr16(pv + v * 32), tr16(pv + v * 32 + 4 * LST128)); S[v] = MFMA16(af, bfr, S[v]); } }
#pragma unroll
            for (int v = 0; v < 8; ++v) { v2u wv; wv.x = pg8::cvt_pk_bf16(S[v][0], S[v][1]); wv.y = pg8::cvt_pk_bf16(S[v][2], S[v][3]); *(LAS v2u*)(ST + (16 * v + c) * LST128 + (16 * w + 4 * kq) * 2) = wv; }
        }
    }
    float* dst = F.out + O_HGP + ((size_t)((o * 4 + b) * 16 + h)) * 16384;
#pragma unroll
    for (int v = 0; v < 8; ++v)
#pragma unroll
        for (int i = 0; i < 4; ++i) dst[(size_t)(16 * w + 4 * kq + i) * 128 + 16 * v + c] = S[v][i];
}

DI void gla_sample(const Frame& F, const Args& A, int o, int u) {
    int tid_ = F.tid; asm volatile("" : "+v"(tid_));
    const int tid = tid_, lane = tid & 63, w = __builtin_amdgcn_readfirstlane(tid >> 6);
    const int b = u >> 2, hq = u & 3;
    LAS float* fq = (LAS float*)F.lds;
    LAS float* fk = fq + 512; LAS float* fs = fk + 512; LAS float* part = fs + 512;
    LAS float* red = part + 2048;
    const bf16* Pr = wsb(F, WS_PB) + (size_t)(MP + 4 * b) * OIN; bf16* MX = wsb(F, WS_MIX) + (size_t)(MP + 4 * b) * D;
    for (int hh = 0; hh < 4; ++hh) {
        const int h = hq * 4 + hh;
        __syncthreads();
        { const int t = tid >> 7, k = tid & 127; const float lbv = hg_lb(A, o, h * 128 + k);
          const float qv = bf2f(Pr[(size_t)t * OIN + h * 128 + k]), fv = bf2f(Pr[(size_t)t * OIN + 2048 + h * 128 + k]);
          const float fg = lbv + (1.f - lbv) * sigm(fv); fq[tid] = fg; fk[tid] = 1.f - fg; fs[tid] = silu(qv); }
        __syncthreads();
        const int v = tid & 127, kg = tid >> 7;
        const float* S0 = A.in[5] + ((size_t)((o * 128 + b) * 16 + h)) * 16384 + (size_t)(32 * kg) * 128 + v;
        float* Sn = F.out + O_HGS + ((size_t)((o * 128 + b) * 16 + h)) * 16384 + (size_t)(32 * kg) * 128 + v;
        float s[32];
#pragma unroll
        for (int i = 0; i < 32; ++i) s[i] = __builtin_nontemporal_load(S0 + (size_t)i * 128);
        float iv[4], acc[4];
#pragma unroll
        for (int t = 0; t < 4; ++t) { iv[t] = bf2f(Pr[(size_t)t * OIN + 4096 + h * 128 + v]); acc[t] = 0.f; }
#pragma unroll
        for (int t = 0; t < 4; ++t)
#pragma unroll
            for (int i = 0; i < 32; ++i) { const int k = 32 * kg + i; s[i] = fq[t * 128 + k] * s[i] + fk[t * 128 + k] * iv[t]; acc[t] += s[i] * fs[t * 128 + k]; }
#pragma unroll
        for (int i = 0; i < 32; ++i) __builtin_nontemporal_store(s[i], Sn + (size_t)i * 128);
#pragma unroll
        for (int t = 0; t < 4; ++t) part[(kg * 4 + t) * 128 + v] = acc[t];
        __syncthreads();
        float ot[4];
        if (tid < 128) {
#pragma unroll
            for (int t = 0; t < 4; ++t) { ot[t] = part[t * 128 + v] + part[(4 + t) * 128 + v] + part[(8 + t) * 128 + v] + part[(12 + t) * 128 + v]; const float q = wave_sum(ot[t] * ot[t]); if (lane == 0) red[w * 4 + t] = q; }
        }
        __syncthreads();
        if (tid < 128) { const float ng = A.in[18][o * 128 + v];
#pragma unroll
            for (int t = 0; t < 4; ++t) { const float rstd = __builtin_amdgcn_rsqf((red[t] + red[4 + t]) * (1.f / 128.f) + NORM_EPS); const float gv = bf2f(Pr[(size_t)t * OIN + 6144 + h * 128 + v]);
                MX[(size_t)t * D + h * 128 + v] = (bf16)f2bf(ot[t] * rstd * ng * sigm(gv)); } }
    }
}

__global__ void __launch_bounds__(NTHR, 2) mega(Args args) {
    extern __shared__ __attribute__((aligned(16))) unsigned char lds_raw[];
    Frame F;
    F.lds = (ldsp)lds_raw; F.MISC = (volatile LAS unsigned*)(F.lds + MISC_OFF);
    F.tid = threadIdx.x; F.lane = F.tid & 63; F.wave = __builtin_amdgcn_readfirstlane(F.tid >> 6);
    F.G = gridDim.x; { const int bx = blockIdx.x; F.vcu = (F.G % 8 == 0) ? (bx % 8) * (F.G / 8) + bx / 8 : bx; }
    F.ws = args.ws; F.out = args.out; F.ctl = (gu32*)(args.ws + WS_CTL);
    if (F.tid < 32) F.MISC[F.tid] = 0u;
    __syncthreads();
    const int lo = args.ph_lo, hi = args.ph_hi;
    XcdBarrier bar; bar.bar = (unsigned*)(F.ctl + CW_BAR); bar.x = 0; bar.st = F.MISC + 8;
    if (hi - lo > 1) bar = xcd_barrier_post((unsigned*)(F.ctl + CW_BAR), F.MISC + 8);
#define IN(k) (lo <= (k) && (k) < hi)
#ifndef EN_MASK
#define EN_MASK 0xffff
#endif
#define EN(i) ((EN_MASK >> (i)) & 1)
#define PF(Fp) Frame Fp = F; asm volatile("" : "+v"(Fp.tid)); Fp.lane = Fp.tid & 63; Fp.wave = __builtin_amdgcn_readfirstlane(Fp.tid >> 6)
#define SEAM(k) do { if ((k) + 1 < hi) xcd_barrier(bar); } while (0)

    if (IN(0)) { PF(Fp); if (EN(0)) p0_prologue(Fp, args); SEAM(0); }

    for (int l = 0; l < 4; ++l) {
        const int pb = 1 + 8 * l, e = l >> 1;
        if (IN(pb)) {
            if ((l & 1) == 0) { if (EN(1)) {
                pg8::Gemm g{wsb(F, WS_XN), wsb(F, WS_WINE) + (size_t)e * EIN * D, M, EIN, D}; pg8::StaticOrder S; S.init(M, EIN, F.G, (int)blockIdx.x);
                pg8::EpiEvenIn E{wsb(F, WS_PB), EIN, wsf(F, WS_ROT), wsf(F, WS_ROT) + 2052 * 128};
                pg8::gemm_phase<pg8::EpiEvenIn, pg8::StaticOrder, true, true>(F.lds, g, S, E); }
            } else if (EN(2)) {
                pg8::Gemm g{wsb(F, WS_XN), wsb(F, WS_WINO) + (size_t)e * OIN * D, M, OIN, D}; pg8::StaticOrder S; S.init(M, OIN, F.G, (int)blockIdx.x);
                pg8::EpiBf16<0> E{wsb(F, WS_PB), OIN, nullptr, 0, 0, 1.f};
                pg8::gemm_phase<pg8::EpiBf16<0>, pg8::StaticOrder, true, true>(F.lds, g, S, E);
            }
            SEAM(pb);
        }
        if (IN(pb + 1)) {
            PF(Fp);
            if ((l & 1) == 0) {
                if (EN(3)) for (int u; (u = q_next(Fp, 8 * l + 0)) < 128;) rglru_unit<false>(Fp, args, e, u);
                if (EN(4)) for (int u; (u = q_next(Fp, 8 * l + 1)) < 256;) { const int b = u >> 6, h = (u >> 4) & 3, qb = u & 15; ret_flash(Fp, b, h, qb); ret_flash(Fp, b, h, 31 - qb); }
                if (EN(5)) for (int u; (u = q_next(Fp, 8 * l + 2)) < 512;) ret_sample(Fp, args, e, u);
                if (EN(6)) for (int u; (u = q_next(Fp, 8 * l + 3)) < 64;) ret_state(Fp, e, u);
                if (EN(7)) for (int u; (u = q_next(Fp, 8 * l + 4)) < 128;) rglru_unit<true>(Fp, args, e, u);
            } else {
                if (EN(8)) for (int u; (u = q_next(Fp, 8 * l + 0)) < 64;) gla_prompt(Fp, args, e, u);
                if (EN(9)) for (int u; (u = q_next(Fp, 8 * l + 1)) < 512;) gla_sample(Fp, args, e, u);
            }
            SEAM(pb + 1);
        }
        if (IN(pb + 2)) { if (EN(10)) {
            const bf16* wt = (l & 1) ? wsb(F, WS_WOUTO) + (size_t)e * D * D : wsb(F, WS_WOUTE) + (size_t)e * D * D;
            pg8::Gemm g{wsb(F, WS_MIX), wt, M, D, D}; pg8::StaticOrder S; S.init(M, D, F.G, (int)blockIdx.x);
            pg8::EpiF32 E{wsf(F, WS_Y), D, nullptr};
            pg8::gemm_phase<pg8::EpiF32, pg8::StaticOrder, true, true>(F.lds, g, S, E); }
            SEAM(pb + 2);
        }
        if (IN(pb + 3)) { PF(Fp); if (EN(11)) ln_phase(Fp, args.in[20] + (size_t)(l * 2) * D, args.in[21] + (size_t)(l * 2) * D, nullptr); SEAM(pb + 3); }
        if (IN(pb + 4)) { if (EN(12)) {
            pg8::Gemm g{wsb(F, WS_XN), wsb(F, WS_WUP) + (size_t)l * NUP * D, M, NUP, D}; pg8::StaticOrder S; S.init(M, NUP, F.G, (int)blockIdx.x);
            pg8::EpiBf16<0> E{wsb(F, WS_UV), NUP, nullptr, 0, 0, 1.f};
            pg8::gemm_phase<pg8::EpiBf16<0>, pg8::StaticOrder, true, true>(F.lds, g, S, E); }
            SEAM(pb + 4);
        }
        if (IN(pb + 5)) { PF(Fp); if (EN(13)) hph_phase(Fp, args, l); SEAM(pb + 5); }
        if (IN(pb + 6)) { if (EN(14)) {
            pg8::Gemm g{wsb(F, WS_H), wsb(F, WS_WDOWN) + (size_t)l * D * DFF, M, D, DFF}; pg8::StaticOrder S; S.init(M, D, F.G, (int)blockIdx.x);
            pg8::EpiF32 E{wsf(F, WS_Y), D, nullptr};
            pg8::gemm_phase<pg8::EpiF32, pg8::StaticOrder, true, true>(F.lds, g, S, E); }
            SEAM(pb + 6);
        }
        if (IN(pb + 7)) { PF(Fp); if (EN(15)) ln_phase(Fp, args.in[20] + (size_t)(l * 2 + 1) * D, args.in[21] + (size_t)(l * 2 + 1) * D, l == 3 ? F.out + O_YP : nullptr); SEAM(pb + 7); }
    }
#undef IN
#undef SEAM
}

extern "C" void kernel_launch(void* const* d_in, const int* in_sizes, int n_in, void* d_out, int out_size, void* d_ws, size_t ws_size, hipStream_t stream) {
    static int grid = 0;
    if (grid == 0) {
        if (n_in != 26 || (size_t)out_size != O_END || ws_size < WS_END) { fprintf(stderr, "kernel_launch: unexpected problem (n_in %d, out %d, ws %zu); nothing launched\n", n_in, out_size, ws_size); grid = -1; return; }
        int dev = 0, cus = 0, per_cu = 0;
        if (hipGetDevice(&dev) != hipSuccess || hipDeviceGetAttribute(&cus, hipDeviceAttributeMultiprocessorCount, dev) != hipSuccess) { grid = -1; return; }
        if (hipFuncSetAttribute((const void*)mega, hipFuncAttributeMaxDynamicSharedMemorySize, LDS_BYTES) != hipSuccess) { fprintf(stderr, "kernel_launch: hipFuncSetAttribute failed\n"); grid = -1; return; }
        if (hipOccupancyMaxActiveBlocksPerMultiprocessor(&per_cu, (const void*)mega, NTHR, LDS_BYTES) != hipSuccess || per_cu < 1) { fprintf(stderr, "kernel_launch: occupancy query reports %d workgroups per CU\n", per_cu); }
        (void)hipGetLastError();
        grid = cus;
    }
    if (grid < 0) return;
    if (hipMemsetAsync((char*)d_ws + WS_CTL, 0, CTL_ZERO_BYTES, stream) != hipSuccess) return;
    Args a{};
    for (int i = 0; i < 26; ++i) a.in[i] = (const float*)d_in[i];
    a.out = (float*)d_out; a.ws = (unsigned char*)d_ws;
#if MK_PER_PHASE
    for (int p = 0; p < NPH; ++p) { a.ph_lo = p; a.ph_hi = p + 1; hipLaunchKernelGGL(mega, dim3(grid), dim3(NTHR), LDS_BYTES, stream, a); }
#else
    a.ph_lo = 0; a.ph_hi = NPH; hipLaunchKernelGGL(mega, dim3(grid), dim3(NTHR), LDS_BYTES, stream, a);
#endif
    const hipError_t le = hipPeekAtLastError();
    if (le != hipSuccess) fprintf(stderr, "kernel_launch: launch failed: %s\n", hipGetErrorName(le));
}
```

```cpp
#include <hip/hip_runtime.h>
#include <cstdio>
#include <cstdint>
#include <cstddef>
namespace pg8 {
#define PG8_LAS __attribute__((address_space(3)))
typedef unsigned short bf16_t;
typedef short bf16x8 __attribute__((ext_vector_type(8)));
typedef float f32x4 __attribute__((ext_vector_type(4)));
typedef unsigned u32x4 __attribute__((ext_vector_type(4)));
constexpr int BM = 256, BK = 64, HALF = 128, HTB = HALF * BK * 2  , STAGE_BYTES = 8 * HTB, NXCD = 8, WGM = 8;

__host__ __device__ __forceinline__ int lds_byte(int r, int c) { const int st = (r >> 4) * 2 + (c >> 5), rr = r & 15, cc = c & 31, ob = rr * 64 + cc * 2; return st * 1024 + (ob ^ (((ob >> 9) & 1) << 5)); }
__host__ __device__ __forceinline__ void stage_rc(int b, int& R, int& C) { const int st = b / 1024, sb = b % 1024, swz = sb ^ (((sb >> 9) & 1) << 5); R = (st >> 1) * 16 + swz / 64; C = (st & 1) * 32 + (swz % 64) / 2; }
__host__ __device__ __forceinline__ int perm32(int rho) { const int n = rho >> 4, i = rho & 15; return 8 * (i >> 2) + 4 * n + (i & 3); }

struct Unit { int pm, pn; };
struct Gemm { const bf16_t* A; const bf16_t* Bt; int M, N, K; };

struct StaticOrder {
    int nM, nN, nwg, G, c;
    __host__ __device__ void init(int M, int N, int G_, int c_) { nM = M / BM; nN = N / BM; nwg = nM * nN; G = G_; c = c_; }
    __host__ __device__ bool next(int i, Unit& u) const {
        const long L = (long)i * G + c; if (L >= nwg) return false;
        int wgid = (int)L; { const int q = nwg / NXCD, r = nwg % NXCD, xcd = wgid % NXCD, off = wgid / NXCD; wgid = (xcd < r ? xcd * (q + 1) : r * (q + 1) + (xcd - r) * q) + off; }
        const int nig = WGM * nN, gid = wgid / nig, fm = gid * WGM, gsz = (nM - fm) < WGM ? (nM - fm) : WGM;
        u.pm = fm + ((wgid % nig) % gsz); u.pn = (wgid % nig) / gsz; return true;
    }
    __device__ __forceinline__ void a_ready(const Unit&) const {}
    __device__ __forceinline__ void done(const Unit&) const {}
};
__device__ __forceinline__ unsigned cvt_pk_bf16(float lo, float hi) { unsigned r; asm volatile("v_cvt_pk_bf16_f32 %0, %1, %2" : "=v"(r) : "v"(lo), "v"(hi)); return r; }
typedef float f32x2 __attribute__((ext_vector_type(2)));
__device__ __forceinline__ f32x2 gelu_pk(f32x2 v) {
    const f32x2 av = __builtin_elementwise_abs(v), d = av * 0.2316418882f + 1.0f;
    f32x2 t; t.x = __builtin_amdgcn_rcpf(d.x); t.y = __builtin_amdgcn_rcpf(d.y);
    f32x2 q = t * 0.5307027145f + (-0.7265760135f); q = q * t + 0.7107068705f; q = q * t + (-0.142248368f); q = q * t + 0.127414796f; q = q * t;
    const f32x2 s = (v * v) * (-0.72134752044f);
    f32x2 e; e.x = __builtin_amdgcn_exp2f(s.x); e.y = __builtin_amdgcn_exp2f(s.y);
    const f32x2 m = v * (q * e), r = v - m;
    f32x2 o; o.x = v.x < 0.f ? m.x : r.x; o.y = v.y < 0.f ? m.y : r.y; return o;
}

template <int ACT  > struct EpiBf16 {
    static constexpr bool PERM = true, AFTER_DRAIN = false; static_assert(ACT == 0 || ACT == 1, "EpiBf16: ACT is 0 (none) or 1 (gelu_pk)");
    bf16_t* O; int ldc; const float* bias; int split_cols; size_t split_stride; float scale0;
    __device__ __forceinline__ void operator()(const f32x4 (&acc)[2][2][4][2], const Unit& u, int wr, int wc, int fr, int fq) const {
        const int row0 = u.pm * BM + wr * 64 + fr; int colt = u.pn * BM; bf16_t* base = O;
        float sc = 1.f; if (split_cols) { const int t = colt / split_cols; base += (size_t)t * split_stride; colt -= t * split_cols; if (t == 0) sc = scale0; }
        const int col0 = colt + wc * 32 + 8 * fq, bcol0 = u.pn * BM + wc * 32 + 8 * fq;
        f32x4 bv[2][2];
#pragma unroll
        for (int bj = 0; bj < 2; ++bj)
#pragma unroll
            for (int n = 0; n < 2; ++n) bv[bj][n] = bias ? *(const f32x4*)(bias + bcol0 + bj * HALF + 4 * n) : (f32x4){0.f, 0.f, 0.f, 0.f};
#pragma unroll
        for (int ai = 0; ai < 2; ++ai)
#pragma unroll
            for (int m = 0; m < 4; ++m) { bf16_t* rowp = base + (size_t)(row0 + ai * HALF + m * 16) * ldc + col0;
#pragma unroll
                for (int bj = 0; bj < 2; ++bj) { f32x4 v0 = acc[ai][bj][m][0] + bv[bj][0], v1 = acc[ai][bj][m][1] + bv[bj][1];
                    if (ACT == 1) { f32x2 a = gelu_pk((f32x2){v0[0], v0[1]}), b = gelu_pk((f32x2){v0[2], v0[3]}), c = gelu_pk((f32x2){v1[0], v1[1]}), d = gelu_pk((f32x2){v1[2], v1[3]});
                        v0 = (f32x4){a.x, a.y, b.x, b.y}; v1 = (f32x4){c.x, c.y, d.x, d.y}; }
                    v0 = v0 * sc; v1 = v1 * sc; u32x4 w; w.x = cvt_pk_bf16(v0[0], v0[1]); w.y = cvt_pk_bf16(v0[2], v0[3]); w.z = cvt_pk_bf16(v1[0], v1[1]); w.w = cvt_pk_bf16(v1[2], v1[3]);
                    *(u32x4*)(rowp + bj * HALF) = w; } }
    }
};
struct EpiF32 {
    static constexpr bool PERM = false, AFTER_DRAIN = false;
    float* C; int ldc; const float* bias;
    __device__ __forceinline__ void operator()(const f32x4 (&acc)[2][2][4][2], const Unit& u, int wr, int wc, int fr, int fq) const {
        const int row0 = u.pm * BM + wr * 64 + fr, col0 = u.pn * BM + wc * 32 + 4 * fq;
        f32x4 bv[2][2];
#pragma unroll
        for (int bj = 0; bj < 2; ++bj)
#pragma unroll
            for (int n = 0; n < 2; ++n) bv[bj][n] = bias ? *(const f32x4*)(bias + col0 + bj * HALF + n * 16) : (f32x4){0.f, 0.f, 0.f, 0.f};
#pragma unroll
        for (int ai = 0; ai < 2; ++ai)
#pragma unroll
            for (int m = 0; m < 4; ++m) { float* rowp = C + (size_t)(row0 + ai * HALF + m * 16) * ldc + col0;
#pragma unroll
                for (int bj = 0; bj < 2; ++bj)
#pragma unroll
                    for (int n = 0; n < 2; ++n) *(f32x4*)(rowp + bj * HALF + n * 16) = acc[ai][bj][m][n] + bv[bj][n]; }
    }
};
struct EpiEvenIn {
    static constexpr bool PERM = true, AFTER_DRAIN = false;
    bf16_t* O; int ldc; const float* rcos; const float* rsin;
    __device__ __forceinline__ void operator()(const f32x4 (&acc)[2][2][4][2], const Unit& u, int wr, int wc, int fr, int fq) const {
        const int row0 = u.pm * BM + wr * 64 + fr; const int col0 = u.pn * BM + wc * 32 + 8 * fq;
        if (u.pn < 8) {
            const float sc = (u.pn >= 4) ? 0.0625f : 1.0f; const int j0 = wc * 32 + 8 * fq;
#pragma unroll
            for (int ai = 0; ai < 2; ++ai)
#pragma unroll
                for (int m = 0; m < 4; ++m) { const int row = row0 + ai * HALF + m * 16; const int pidx = row < 8192 ? (row & 2047) : 2048 + (row & 3);
                    const float* cp = rcos + pidx * 128 + j0; const float* sp = rsin + pidx * 128 + j0;
                    const f32x4 c0 = *(const f32x4*)cp, c1 = *(const f32x4*)(cp + 4), s0 = *(const f32x4*)sp, s1 = *(const f32x4*)(sp + 4);
                    const f32x4 a0 = acc[ai][0][m][0], a1 = acc[ai][0][m][1], b0 = acc[ai][1][m][0], b1 = acc[ai][1][m][1];
                    const f32x4 o10 = (a0 * c0 - b0 * s0) * sc, o11 = (a1 * c1 - b1 * s1) * sc, o20 = (b0 * c0 + a0 * s0) * sc, o21 = (b1 * c1 + a1 * s1) * sc;
                    bf16_t* rowp = O + (size_t)row * ldc + col0;
                    u32x4 w; w.x = cvt_pk_bf16(o10[0], o10[1]); w.y = cvt_pk_bf16(o10[2], o10[3]); w.z = cvt_pk_bf16(o11[0], o11[1]); w.w = cvt_pk_bf16(o11[2], o11[3]);
                    *(u32x4*)(rowp) = w;
                    w.x = cvt_pk_bf16(o20[0], o20[1]); w.y = cvt_pk_bf16(o20[2], o20[3]); w.z = cvt_pk_bf16(o21[0], o21[1]); w.w = cvt_pk_bf16(o21[2], o21[3]);
                    *(u32x4*)(rowp + HALF) = w; }
        } else {
#pragma unroll
            for (int ai = 0; ai < 2; ++ai)
#pragma unroll
                for (int m = 0; m < 4; ++m) { bf16_t* rowp = O + (size_t)(row0 + ai * HALF + m * 16) * ldc + col0;
#pragma unroll
                    for (int bj = 0; bj < 2; ++bj) { const f32x4 v0 = acc[ai][bj][m][0], v1 = acc[ai][bj][m][1];
                        u32x4 w; w.x = cvt_pk_bf16(v0[0], v0[1]); w.y = cvt_pk_bf16(v0[2], v0[3]); w.z = cvt_pk_bf16(v1[0], v1[1]); w.w = cvt_pk_bf16(v1[2], v1[3]);
                        *(u32x4*)(rowp + bj * HALF) = w; } }
        }
    }
};
template <class Epi, class Sched, bool ALIGN_EPI = false, bool SP2 = false>
__device__ __forceinline__ void gemm_phase(PG8_LAS unsigned char* lds, const Gemm g, const Sched& S, const Epi& E) {
    int tid_ = threadIdx.x; asm volatile("" : "+v"(tid_));
    const int tid = tid_, wid = __builtin_amdgcn_readfirstlane(tid >> 6), lane = tid & 63, wr = wid >> 2, wc = wid & 3, fr = lane & 15, fq = lane >> 4;
    const int K = g.K, nt = K / BK;
    unsigned voffA[2], voffB[2];
#pragma unroll
    for (int i = 0; i < 2; ++i) { int R, C; stage_rc(tid * 16 + i * 8192, R, C); const int Rb = Epi::PERM ? ((R & ~31) + perm32(R & 31)) : R;
        voffA[i] = (unsigned)(R * K + C) * 2u; voffB[i] = (unsigned)(Rb * K + C) * 2u; }
    const size_t kstep = (size_t)(BK * 2);
    const size_t hstep = (size_t)HALF * K * 2;
    const size_t tstep = 2 * hstep;
    const unsigned ldsw = (unsigned)wid * 1024u;
    const int aoff = lds_byte(wr * 64 + fr, fq * 8), boff = lds_byte(wc * 32 + fr, fq * 8);
#define PG8_SA(b, h) (((b) * 2 + (h)) * HTB)
#define PG8_SB(b, h) ((4 + (b) * 2 + (h)) * HTB)
#define PG8_STAGE(bufoff, gbase, voff) do { _Pragma("unroll") for (int _i = 0; _i < 2; ++_i) \
        __builtin_amdgcn_global_load_lds((const unsigned*)((const char*)(gbase) + (voff)[_i]), (PG8_LAS unsigned*)(lds + (bufoff) + ldsw + _i * 8192), 16, 0, 0); } while (0)
#define PG8_LDA(dst, b, h) do { _Pragma("unroll") for (int m = 0; m < 4; ++m) _Pragma("unroll") for (int k = 0; k < 2; ++k) dst[m][k] = *(const PG8_LAS bf16x8*)(lds + PG8_SA(b, h) + aoff + m * 2048 + k * 1024); } while (0)
#define PG8_LDB(dst, b, h) do { _Pragma("unroll") for (int n = 0; n < 2; ++n) _Pragma("unroll") for (int k = 0; k < 2; ++k) dst[n][k] = *(const PG8_LAS bf16x8*)(lds + PG8_SB(b, h) + boff + n * 2048 + k * 1024); } while (0)
#define PG8_MMA(ai, bj, At, Bt) do { __builtin_amdgcn_s_setprio(1); _Pragma("unroll") for (int m = 0; m < 4; ++m) _Pragma("unroll") for (int n = 0; n < 2; ++n) _Pragma("unroll") for (int k = 0; k < 2; ++k) \
        acc[ai][bj][m][n] = __builtin_amdgcn_mfma_f32_16x16x32_bf16(Bt[n][k], At[m][k], acc[ai][bj][m][n], 0, 0, 0); __builtin_amdgcn_s_setprio(0); } while (0)
#define PG8_WAIT_V(n) asm volatile("s_waitcnt vmcnt(" #n ")" ::: "memory")
#define PG8_WAIT_L(n) asm volatile("s_waitcnt lgkmcnt(" #n ")" ::: "memory")
#define PG8_BAR __builtin_amdgcn_s_barrier()
#define PG8_SCHED __builtin_amdgcn_sched_barrier(0)
    Unit cur, nxt; int ui = 0;
    if (!S.next(0, cur)) return;
    f32x4 acc[2][2][4][2];
#pragma unroll
    for (int a = 0; a < 2; ++a)
#pragma unroll
        for (int b = 0; b < 2; ++b)
#pragma unroll
            for (int m = 0; m < 4; ++m)
#pragma unroll
                for (int n = 0; n < 2; ++n) acc[a][b][m][n] = (f32x4){0.f, 0.f, 0.f, 0.f};
    bf16x8 At[4][2], B0[2][2], B1[2][2];
    const char* cA = (const char*)g.A + (size_t)cur.pm * tstep; const char* cB = (const char*)g.Bt + (size_t)cur.pn * tstep;
    S.a_ready(cur);
    if constexpr (SP2) {
        PG8_STAGE(PG8_SB(0, 0), cB, voffB); PG8_STAGE(PG8_SB(0, 1), cB + hstep, voffB); PG8_STAGE(PG8_SA(0, 0), cA, voffA); PG8_STAGE(PG8_SA(0, 1), cA + hstep, voffA);
        if (wr == 1) PG8_BAR;
        PG8_WAIT_V(2); PG8_BAR;
        PG8_STAGE(PG8_SB(1, 0), cB + kstep, voffB); PG8_STAGE(PG8_SA(1, 0), cA + kstep, voffA); PG8_STAGE(PG8_SB(1, 1), cB + hstep + kstep, voffB);
        PG8_WAIT_V(6); PG8_BAR;
    } else {
        PG8_STAGE(PG8_SB(0, 0), cB, voffB); PG8_STAGE(PG8_SA(0, 0), cA, voffA); PG8_STAGE(PG8_SB(0, 1), cB + hstep, voffB); PG8_STAGE(PG8_SA(0, 1), cA + hstep, voffA);
        if (wr == 1) PG8_BAR;
        PG8_WAIT_V(4); PG8_BAR;
        PG8_STAGE(PG8_SB(1, 0), cB + kstep, voffB); PG8_STAGE(PG8_SA(1, 0), cA + kstep, voffA); PG8_STAGE(PG8_SB(1, 1), cB + hstep + kstep, voffB);
        PG8_WAIT_V(6); PG8_BAR;
    }
    for (;;) {
        const bool has_next = S.next(ui + 1, nxt);
        const char* nA = has_next ? (const char*)g.A + (size_t)nxt.pm * tstep : cA; const char* nB = has_next ? (const char*)g.Bt + (size_t)nxt.pn * tstep : cB;
        for (int t = 0; t < nt; t += 2) {
            const bool last = (t == nt - 2);
            const char* a1 = cA + (size_t)(t + 1) * kstep;
            const char* a2 = last ? nA : cA + (size_t)(t + 2) * kstep; const char* b2 = last ? nB : cB + (size_t)(t + 2) * kstep;
            const char* a3 = a2 + kstep; const char* b3 = b2 + kstep;
            if (last && has_next) S.a_ready(nxt);
            if constexpr (SP2) {
            PG8_LDB(B0, 0, 0); PG8_LDB(B1, 0, 1); PG8_SCHED; PG8_LDA(At, 0, 0); PG8_STAGE(PG8_SA(1, 1), a1 + hstep, voffA);
            PG8_WAIT_V(8); PG8_WAIT_L(0); PG8_BAR; PG8_MMA(0, 0, At, B0); PG8_MMA(0, 1, At, B1); PG8_BAR; PG8_SCHED;
            PG8_LDA(At, 0, 1); PG8_STAGE(PG8_SB(0, 0), b2, voffB); PG8_STAGE(PG8_SB(0, 1), b2 + hstep, voffB); PG8_STAGE(PG8_SA(0, 0), a2, voffA);
            PG8_WAIT_V(8); PG8_WAIT_L(0); PG8_BAR; PG8_MMA(1, 0, At, B0); PG8_MMA(1, 1, At, B1); PG8_BAR; PG8_SCHED;
            PG8_LDB(B0, 1, 0); PG8_LDB(B1, 1, 1); PG8_SCHED; PG8_LDA(At, 1, 0); PG8_STAGE(PG8_SA(0, 1), a2 + hstep, voffA);
            PG8_WAIT_V(8); PG8_WAIT_L(0); PG8_BAR; PG8_MMA(0, 0, At, B0); PG8_MMA(0, 1, At, B1); PG8_BAR; PG8_SCHED;
            PG8_LDA(At, 1, 1); PG8_STAGE(PG8_SB(1, 0), b3, voffB); PG8_STAGE(PG8_SB(1, 1), b3 + hstep, voffB); PG8_STAGE(PG8_SA(1, 0), a3, voffA);
            PG8_WAIT_V(8); PG8_WAIT_L(0); PG8_BAR; PG8_MMA(1, 0, At, B0); PG8_MMA(1, 1, At, B1); PG8_BAR; PG8_SCHED;
            } else {
            PG8_LDB(B0, 0, 0); PG8_SCHED; PG8_LDA(At, 0, 0); PG8_STAGE(PG8_SA(1, 1), a1 + hstep, voffA);
            PG8_WAIT_L(8); PG8_BAR; PG8_WAIT_L(0); PG8_MMA(0, 0, At, B0); PG8_BAR; PG8_SCHED;
            PG8_LDB(B1, 0, 1); PG8_STAGE(PG8_SB(0, 0), b2, voffB);
            PG8_BAR; PG8_WAIT_L(0); PG8_MMA(0, 1, At, B1); PG8_BAR;
            PG8_LDA(At, 0, 1); PG8_STAGE(PG8_SA(0, 0), a2, voffA);
            PG8_BAR; PG8_WAIT_L(0); PG8_MMA(1, 0, At, B0); PG8_BAR; PG8_SCHED;
            PG8_STAGE(PG8_SB(0, 1), b2 + hstep, voffB);
            PG8_WAIT_V(6); PG8_BAR; PG8_MMA(1, 1, At, B1); PG8_BAR;
            PG8_LDB(B0, 1, 0); PG8_SCHED; PG8_LDA(At, 1, 0); PG8_STAGE(PG8_SA(0, 1), a2 + hstep, voffA);
            PG8_WAIT_L(8); PG8_BAR; PG8_WAIT_L(0); PG8_MMA(0, 0, At, B0); PG8_BAR; PG8_SCHED;
            PG8_LDB(B1, 1, 1); PG8_STAGE(PG8_SB(1, 0), b3, voffB);
            PG8_BAR; PG8_WAIT_L(0); PG8_MMA(0, 1, At, B1); PG8_BAR;
            PG8_LDA(At, 1, 1); PG8_STAGE(PG8_SA(1, 0), a3, voffA);
            PG8_BAR; PG8_WAIT_L(0); PG8_MMA(1, 0, At, B0); PG8_BAR; PG8_SCHED;
            PG8_STAGE(PG8_SB(1, 1), b3 + hstep, voffB);
            PG8_WAIT_V(6); PG8_BAR; PG8_MMA(1, 1, At, B1); PG8_BAR;
            }
        }
        if constexpr (ALIGN_EPI) { if (wr == 0) PG8_BAR; }
        if constexpr (!Epi::AFTER_DRAIN) { E(acc, cur, wr, wc, fr, fq); S.done(cur); }
        if (!has_next) break;
#pragma unroll
        for (int a = 0; a < 2; ++a)
#pragma unroll
            for (int b = 0; b < 2; ++b)
#pragma unroll
                for (int m = 0; m < 4; ++m)
#pragma unroll
                    for (int n = 0; n < 2; ++n) acc[a][b][m][n] = (f32x4){0.f, 0.f, 0.f, 0.f};
        cur = nxt; cA = nA; cB = nB; ++ui;
        if constexpr (ALIGN_EPI) { if (wr == 1) PG8_BAR; }
    }
    PG8_WAIT_V(0);
    if constexpr (!ALIGN_EPI) { if (wr == 0) PG8_BAR; }
    PG8_BAR;
    if constexpr (Epi::AFTER_DRAIN) { E.fused(acc, cur, wr, wc, fr, fq, lds, wid, lane); S.done(cur); }
#undef PG8_SA
#undef PG8_SB
#undef PG8_STAGE
#undef PG8_LDA
#undef PG8_LDB
#undef PG8_MMA
#undef PG8_WAIT_V
#undef PG8_WAIT_L
#undef PG8_BAR
#undef PG8_SCHED
}
}

constexpr int NWAVES = 8, NTHR = 512;
constexpr int M = 8704, MP = 8192, D = 2048, DFF = 5632, NUP = 11264, EIN = 6144, OIN = 8192;
constexpr int NPH = 33;
#ifndef MK_PER_PHASE
#define MK_PER_PHASE 0
#endif
constexpr float DN_ALPHA = 1.6817928305074290f;
constexpr float LN_EPS = 1e-5f, NORM_EPS = 1e-6f;
constexpr size_t O_YP = 0, O_YS = O_YP + 16777216, O_RETP = O_YS + 1048576, O_RETS = O_RETP + 2097152, O_RGHP = O_RETS + 67108864, O_RGHS = O_RGHP + 8192,
                 O_RGCP = O_RGHS + 262144, O_RGCS = O_RGCP + 24576, O_HGP = O_RGCS + 786432, O_HGS = O_HGP + 2097152, O_FCP = O_HGS + 67108864, O_FCS = O_FCP + 180224, O_END = O_FCS + 5767168;
constexpr size_t MiB = 1u << 20;
constexpr size_t WS_CTL = 0, CTL_ZERO_BYTES = 1 * MiB;
constexpr size_t WS_ROT = 1 * MiB, WS_RGW = 4 * MiB, WS_WINE = 5 * MiB, WS_WOUTE = 53 * MiB, WS_WINO = 69 * MiB, WS_WOUTO = 133 * MiB, WS_WUP = 149 * MiB, WS_WDOWN = 325 * MiB;
constexpr size_t WS_X = 413 * MiB, WS_XN = 481 * MiB, WS_PB = 515 * MiB, WS_MIX = 651 * MiB, WS_Y = 685 * MiB, WS_UV = 753 * MiB, WS_H = 940 * MiB, WS_END = 1034 * MiB;
constexpr int CW_TMO = 0, CW_CODE = 1, CW_BAR = 4096, CW_Q = 16384;
constexpr int MISC_OFF = 143360, LDS_BYTES = 147456;

#define GAS __attribute__((address_space(1)))
#define LAS __attribute__((address_space(3)))
#define DI __device__ __forceinline__
typedef unsigned short bf16;
typedef unsigned v4u __attribute__((ext_vector_type(4)));
typedef unsigned v2u __attribute__((ext_vector_type(2)));
typedef float f32x4 __attribute__((ext_vector_type(4)));
typedef short bf16x8 __attribute__((ext_vector_type(8)));
typedef short s16x4 __attribute__((ext_vector_type(4)));
typedef short v4i16_t __attribute__((ext_vector_type(4)));
typedef LAS unsigned char* ldsp;
typedef GAS unsigned gu32;
#define RLX_AGENT __ATOMIC_RELAXED, __HIP_MEMORY_SCOPE_AGENT
DI unsigned f2bf(float f) { unsigned u = __builtin_bit_cast(unsigned, f); return (u + 0x7fffu + ((u >> 16) & 1u)) >> 16; }
DI unsigned pk2(float lo, float hi) { return f2bf(lo) | (f2bf(hi) << 16); }
DI float bflo(unsigned w) { return __builtin_bit_cast(float, w << 16); }
DI float bfhi(unsigned w) { return __builtin_bit_cast(float, w & 0xffff0000u); }
DI float bf2f(bf16 v) { return __builtin_bit_cast(float, ((unsigned)v) << 16); }
DI float ex2(float x) { return __builtin_amdgcn_exp2f(x); }
DI float fexp(float x) { return __builtin_amdgcn_exp2f(x * 1.4426950408889634f); }
DI float flog(float x) { return __builtin_amdgcn_logf(x) * 0.6931471805599453f; }
DI float frcp(float x) { return __builtin_amdgcn_rcpf(x); }
DI float sigm(float x) { return frcp(1.0f + fexp(-x)); }
DI float silu(float x) { return x * sigm(x); }
DI float gelu_t(float x) { return x * sigm(1.5957691216057308f * (x + 0.044715f * x * x * x)); }
DI s16x4 tr16(const LAS unsigned char* p) { return __builtin_bit_cast(s16x4, __builtin_amdgcn_ds_read_tr16_b64_v4i16((LAS v4i16_t*)p)); }
DI bf16x8 cat44(s16x4 a, s16x4 b) { bf16x8 r; r[0] = a[0]; r[1] = a[1]; r[2] = a[2]; r[3] = a[3]; r[4] = b[0]; r[5] = b[1]; r[6] = b[2]; r[7] = b[3]; return r; }
DI bf16x8 pack8(f32x4 a, f32x4 b) { v4u w; w.x = pg8::cvt_pk_bf16(a[0], a[1]); w.y = pg8::cvt_pk_bf16(a[2], a[3]); w.z = pg8::cvt_pk_bf16(b[0], b[1]); w.w = pg8::cvt_pk_bf16(b[2], b[3]); return __builtin_bit_cast(bf16x8, w); }
#define MFMA16(a, b, c) __builtin_amdgcn_mfma_f32_16x16x32_bf16((a), (b), (c), 0, 0, 0)
DI float wave_sum(float v) {
#pragma unroll
    for (int o = 1; o < 64; o <<= 1) v += __shfl_xor(v, o);
    return v;
}
#define XB_TMO      128
#define XB_XCNT(j)  (256  + 64 * (j))
#define XB_XSUB(j)  (1280 + 64 * (j))
#define XB_XGEN(j)  (2304 + 64 * (j))
#define XB_TOP      3328
#define XB_TOPGEN   3392
#define XCD_BAR_WORDS 3456
#define XB_SPIN_CAP (1u << 18)

__device__ __forceinline__ unsigned xb_ld(unsigned* p)              { return __hip_atomic_load(p, __ATOMIC_RELAXED, __HIP_MEMORY_SCOPE_AGENT); }
__device__ __forceinline__ unsigned xb_add(unsigned* p, unsigned v) { return __hip_atomic_fetch_add(p, v, __ATOMIC_RELAXED, __HIP_MEMORY_SCOPE_AGENT); }
__device__ __forceinline__ unsigned xb_xcc_id() { return (unsigned)__builtin_amdgcn_s_getreg((3 << 11) | 20) & 0xFu; }
#define XB_SPIN(cond, bar) do { unsigned _sp = 0; while (cond) { __builtin_amdgcn_s_sleep(1); \
    if ((++_sp & 255u) == 0u) { if (xb_ld(&(bar)[XB_TMO])) break; if (_sp > XB_SPIN_CAP) { atomicAdd(&(bar)[XB_TMO], 1u); break; } } } } while (0)

struct XcdBarrier {
    unsigned* bar; unsigned x;
    volatile LAS unsigned* st;
};

__device__ __forceinline__ XcdBarrier xcd_barrier_post(unsigned* bar, volatile LAS unsigned* st) {
    XcdBarrier b; b.bar = bar; b.x = xb_xcc_id(); b.st = st;
    if (threadIdx.x == 0) (void)xb_add(&bar[XB_XCNT(b.x)], 1u);
    return b;
}
__device__ __forceinline__ void xcd_barrier_complete(unsigned* bar, unsigned x, unsigned& nloc, unsigned& nx) {
    const unsigned G = gridDim.x * gridDim.y * gridDim.z;
    unsigned sum, cnt, mine, sp = 0u;
    for (;;) {
        sum = 0u; cnt = 0u; mine = 0u;
#pragma unroll
        for (unsigned j = 0; j < 16; ++j) { const unsigned c = xb_ld(&bar[XB_XCNT(j)]); sum += c; cnt += (c > 0u) ? 1u : 0u; mine = (j == x) ? c : mine; }
        if (sum == G) break;
        __builtin_amdgcn_s_sleep(1);
        if ((++sp & 255u) == 0u) { if (xb_ld(&bar[XB_TMO])) break; if (sp > XB_SPIN_CAP) { atomicAdd(&bar[XB_TMO], 1u); break; } }
    }
    nloc = mine > 0u ? mine : 1u; nx = cnt > 0u ? cnt : 1u;
}

__device__ __forceinline__ void xcd_barrier(const XcdBarrier& b) {
    asm volatile("s_waitcnt vmcnt(0)" ::: "memory");
    __syncthreads();
    if (threadIdx.x == 0) {
        unsigned* bar = b.bar;
        __builtin_amdgcn_s_waitcnt(0);
        unsigned nloc = b.st[0], nx = b.st[1];
        if (nloc == 0u) { xcd_barrier_complete(bar, b.x, nloc, nx); b.st[0] = nloc; b.st[1] = nx; }
        const unsigned old = xb_add(&bar[XB_XSUB(b.x)], 1u);
        const unsigned gen = old / nloc;
        if (old + 1u == (gen + 1u) * nloc) {
            __builtin_amdgcn_fence(__ATOMIC_RELEASE, "agent");
            asm volatile("s_waitcnt vmcnt(0)" ::: "memory");
            const unsigned og = xb_add(&bar[XB_TOP], 1u);
            const unsigned tg = og / nx;
            if (og + 1u == (tg + 1u) * nx) xb_add(&bar[XB_TOPGEN], 1u);
            else XB_SPIN(xb_ld(&bar[XB_TOPGEN]) == tg, bar);
            __builtin_amdgcn_fence(__ATOMIC_ACQUIRE, "agent");
            xb_add(&bar[XB_XGEN(b.x)], 1u);
            asm volatile("s_waitcnt vmcnt(0)" ::: "memory");
        } else {
            XB_SPIN(xb_ld(&bar[XB_XGEN(b.x)]) == gen, bar);
            __builtin_amdgcn_fence(__ATOMIC_ACQUIRE, "agent");
            asm volatile("s_waitcnt vmcnt(0)" ::: "memory");
        }
    }
    __syncthreads();
}

struct Args { const float* in[26]; float* out; unsigned char* ws; int ph_lo, ph_hi; };
struct Frame {
    ldsp lds; volatile LAS unsigned* MISC; gu32* ctl;
    int tid, lane, wave, vcu, G;
    unsigned char* ws; float* out;
};
DI bf16* wsb(const Frame& F, size_t off) { return (bf16*)(F.ws + off); }
DI float* wsf(const Frame& F, size_t off) { return (float*)(F.ws + off); }
DI int q_next(const Frame& F, int qi) {
    __syncthreads();
    if (F.tid == 0) F.MISC[0] = __hip_atomic_fetch_add(F.ctl + CW_Q + 64 * qi, 1u, RLX_AGENT);
    __syncthreads();
    return (int)F.MISC[0];
}

DI void p0_transpose_item(const float* W, int K, int N, bf16* WT, LAS float* scr, int item, int lane) {
    const int nblk = N / 32, kb = item / nblk, nb = item % nblk, k0 = 64 * kb, n0 = 32 * nb;
#pragma unroll 8
    for (int i = 0; i < 32; ++i) { const int kk = 2 * i + (lane >> 5); scr[kk * 33 + (lane & 31)] = W[(size_t)(k0 + kk) * N + n0 + (lane & 31)]; }
    asm volatile("s_waitcnt lgkmcnt(0)" ::: "memory");
    const int c = lane & 7;
#pragma unroll
    for (int j = 0; j < 4; ++j) { const int n = (lane >> 3) + 8 * j; const LAS float* s = scr + (8 * c) * 33 + n;
        v4u o; o.x = pk2(s[0 * 33], s[1 * 33]); o.y = pk2(s[2 * 33], s[3 * 33]); o.z = pk2(s[4 * 33], s[5 * 33]); o.w = pk2(s[6 * 33], s[7 * 33]);
        *(GAS v4u*)(WT + (size_t)(n0 + n) * K + k0 + 8 * c) = o; }
    asm volatile("s_waitcnt lgkmcnt(0)" ::: "memory");
}
DI void xpose_all(const Frame& F, const float* W, int K, int N, bf16* WT, int nmat, LAS float* scr) {
    const int per = (K / 64) * (N / 32), total = per * nmat; const int gw = F.vcu * NWAVES + F.wave, NGW = F.G * NWAVES;
    for (int it = gw; it < total; it += NGW) { const int mt = it / per, r = it - mt * per; p0_transpose_item(W + (size_t)mt * K * N, K, N, WT + (size_t)mt * K * N, scr, r, F.lane); }
}
DI void sincos_d(double x, double& s, double& c) {
    const double x2 = x * x; double ts = 1.0, tc = 1.0;
#pragma unroll
    for (int k = 13; k >= 1; --k) { ts = 1.0 - ts * x2 / (double)((2 * k) * (2 * k + 1)); tc = 1.0 - tc * x2 / (double)((2 * k - 1) * (2 * k)); }
    s = x * ts; c = tc;
}
DI void p0_prologue(const Frame& F, const Args& A) {
    LAS float* scr = (LAS float*)(F.lds + F.wave * 16384);
    xpose_all(F, A.in[7], D, EIN, wsb(F, WS_WINE), 2, scr);
    xpose_all(F, A.in[8], D, D, wsb(F, WS_WOUTE), 2, scr);
    xpose_all(F, A.in[16], D, OIN, wsb(F, WS_WINO), 2, scr);
    xpose_all(F, A.in[17], D, D, wsb(F, WS_WOUTO), 2, scr);
    xpose_all(F, A.in[22], D, NUP, wsb(F, WS_WUP), 4, scr);
    xpose_all(F, A.in[25], DFF, D, wsb(F, WS_WDOWN), 4, scr);
    xpose_all(F, A.in[11], 128, 128, wsb(F, WS_RGW), 16, scr);
    xpose_all(F, A.in[13], 128, 128, wsb(F, WS_RGW) + 16 * 16384, 16, scr);
    const int gt = (F.vcu * NWAVES + F.wave) * 64 + F.lane, NT = F.G * NTHR;
    { const f32x4* xp = (const f32x4*)A.in[0]; const f32x4* xs = (const f32x4*)A.in[1]; f32x4* X = (f32x4*)wsf(F, WS_X); v2u* XN = (v2u*)wsb(F, WS_XN);
      const int np = MP * D / 4, nall = M * D / 4;
      for (int i = gt; i < nall; i += NT) { const f32x4 v = i < np ? xp[i] : xs[i - np]; X[i] = v; v2u w; w.x = pk2(v[0], v[1]); w.y = pk2(v[2], v[3]); XN[i] = w; } }
    { float* rc = wsf(F, WS_ROT); float* rs = rc + 2052 * 128;
      for (int i = gt; i < 2052 * 128; i += NT) { const int pidx = i >> 7, j = i & 127; const int pos = pidx < 2048 ? pidx : 16384 + (pidx - 2048);
          double inv = 1.0, bse = 0.9305720409296989792906463164991290590767; int jj = j;
#pragma unroll
          for (int b = 0; b < 7; ++b) { if (jj & 1) inv *= bse; bse *= bse; jj >>= 1; }
          const double ang = (double)pos * inv; const double n = __builtin_rint(ang * 0.15915494309189533577); const double r = ang - n * 6.283185307179586476925286766559;
          double s, c; sincos_d(r, s, c); rc[i] = (float)c; rs[i] = (float)s; } }
}

DI void ln_phase(const Frame& F, const float* g, const float* bta, float* yout) {
    const int gw = F.vcu * NWAVES + F.wave, NGW = F.G * NWAVES;
    float* X = wsf(F, WS_X); const float* Y = wsf(F, WS_Y); bf16* XN = wsb(F, WS_XN);
    for (int m = gw; m < M; m += NGW) {
        GAS f32x4* xr = (GAS f32x4*)(X + (size_t)m * D) + F.lane; const GAS f32x4* yr = (const GAS f32x4*)(Y + (size_t)m * D) + F.lane;
        f32x4 v[8]; float s = 0.f;
#pragma unroll
        for (int j = 0; j < 8; ++j) { v[j] = xr[64 * j] * DN_ALPHA + yr[64 * j]; s += (v[j][0] + v[j][1]) + (v[j][2] + v[j][3]); }
        const float mean = wave_sum(s) * (1.f / D); float s2 = 0.f;
#pragma unroll
        for (int j = 0; j < 8; ++j) { v[j] = v[j] - mean; s2 += (v[j][0] * v[j][0] + v[j][1] * v[j][1]) + (v[j][2] * v[j][2] + v[j][3] * v[j][3]); }
        const float rstd = 1.f / sqrtf(wave_sum(s2) * (1.f / D) + LN_EPS);
        GAS v2u* o8 = (GAS v2u*)(XN + (size_t)m * D) + F.lane;
#pragma unroll
        for (int j = 0; j < 8; ++j) { const f32x4 gg = ((const f32x4*)g)[F.lane + 64 * j], bb = ((const f32x4*)bta)[F.lane + 64 * j]; const f32x4 o = v[j] * rstd * gg + bb;
            xr[64 * j] = o; v2u w; w.x = pk2(o[0], o[1]); w.y = pk2(o[2], o[3]); o8[64 * j] = w;
            if (yout) ((f32x4*)(yout + (size_t)m * D))[F.lane + 64 * j] = o; }
    }
}
DI void hph_phase(const Frame& F, const Args& A, int l) {
    const int gt = (F.vcu * NWAVES + F.wave) * 64 + F.lane, NT = F.G * NTHR;
    const bf16* UV = wsb(F, WS_UV); bf16* H = wsb(F, WS_H);
    const float* cw = A.in[23] + (size_t)l * 3 * DFF; const float* cb = A.in[24] + (size_t)l * DFF; const float* sbuf = A.in[6] + (size_t)l * 128 * 2 * DFF;
    float* fcp = F.out + O_FCP + (size_t)l * 4 * 2 * DFF; float* fcs = F.out + O_FCS + (size_t)l * 128 * 2 * DFF;
    constexpr int NCH = DFF / 8;
    for (int it = gt; it < M * NCH; it += NT) {
        const int r = it / NCH, ch = it - r * NCH, c0 = ch * 8;
        const v4u u0 = *(const v4u*)(UV + (size_t)r * NUP + c0), vv = *(const v4u*)(UV + (size_t)r * NUP + DFF + c0);
        float um1[8], um2[8], uc[8];
        uc[0] = bflo(u0.x); uc[1] = bfhi(u0.x); uc[2] = bflo(u0.y); uc[3] = bfhi(u0.y); uc[4] = bflo(u0.z); uc[5] = bfhi(u0.z); uc[6] = bflo(u0.w); uc[7] = bfhi(u0.w);
        int t, T; const float* b0 = nullptr;
        if (r < MP) { t = r & 2047; T = 2048; } else { t = r & 3; T = 4; b0 = sbuf + (size_t)((r - MP) >> 2) * 2 * DFF + c0; }
#pragma unroll
        for (int k = 0; k < 8; ++k) { um1[k] = 0.f; um2[k] = 0.f; }
        if (t >= 1) { const v4u w = *(const v4u*)(UV + (size_t)(r - 1) * NUP + c0); um1[0] = bflo(w.x); um1[1] = bfhi(w.x); um1[2] = bflo(w.y); um1[3] = bfhi(w.y); um1[4] = bflo(w.z); um1[5] = bfhi(w.z); um1[6] = bflo(w.w); um1[7] = bfhi(w.w); }
        else if (b0) {
#pragma unroll
            for (int k = 0; k < 8; ++k) um1[k] = b0[DFF + k]; }
        if (t >= 2) { const v4u w = *(const v4u*)(UV + (size_t)(r - 2) * NUP + c0); um2[0] = bflo(w.x); um2[1] = bfhi(w.x); um2[2] = bflo(w.y); um2[3] = bfhi(w.y); um2[4] = bflo(w.z); um2[5] = bfhi(w.z); um2[6] = bflo(w.w); um2[7] = bfhi(w.w); }
        else if (b0) {
#pragma unroll
            for (int k = 0; k < 8; ++k) um2[k] = b0[(t == 1 ? DFF : 0) + k]; }
        float vf[8]; vf[0] = bflo(vv.x); vf[1] = bfhi(vv.x); vf[2] = bflo(vv.y); vf[3] = bfhi(vv.y); vf[4] = bflo(vv.z); vf[5] = bfhi(vv.z); vf[6] = bflo(vv.w); vf[7] = bfhi(vv.w);
        float h[8];
#pragma unroll
        for (int k = 0; k < 8; ++k) { const float y = cw[c0 + k] * um2[k] + cw[DFF + c0 + k] * um1[k] + cw[2 * DFF + c0 + k] * uc[k] + cb[c0 + k]; h[k] = gelu_t(y) * vf[k]; }
        v4u o; o.x = pk2(h[0], h[1]); o.y = pk2(h[2], h[3]); o.z = pk2(h[4], h[5]); o.w = pk2(h[6], h[7]);
        *(v4u*)(H + (size_t)r * DFF + c0) = o;
        if (t >= T - 2) { float* dst = (r < MP) ? fcp + ((size_t)(r >> 11) * 2 + (t - (T - 2))) * DFF + c0 : fcs + ((size_t)((r - MP) >> 2) * 2 + (t - (T - 2))) * DFF + c0;
            *(f32x4*)dst = (f32x4){uc[0], uc[1], uc[2], uc[3]}; *(f32x4*)(dst + 4) = (f32x4){uc[4], uc[5], uc[6], uc[7]}; }
    }
}

constexpr int LST256 = 544, LST128 = 288, LST64 = 160;

DI void ret_flash(const Frame& F, int b, int h, int qb) {
    int tid_ = F.tid; asm volatile("" : "+v"(tid_));
    const int tid = tid_, lane = tid & 63, w = __builtin_amdgcn_readfirstlane(tid >> 6), tb = w >> 1, vh = w & 1, c = lane & 15, kq = lane >> 4;
    ldsp Ks = F.lds, Vs = F.lds + 64 * LST256; LAS float* red = (LAS float*)(F.lds + 2 * 64 * LST256);
    const bf16* Pb = wsb(F, WS_PB) + (size_t)(b * 2048) * EIN; bf16* MX = wsb(F, WS_MIX) + (size_t)(b * 2048) * D;
    const int t0 = qb * 64;
    bf16x8 qf[8];
    { const bf16* qp = Pb + (size_t)(t0 + 16 * tb + c) * EIN + h * 256 + 8 * kq;
#pragma unroll
      for (int ks = 0; ks < 8; ++ks) qf[ks] = *(const bf16x8*)(qp + 32 * ks); }
    f32x4 o[8];
#pragma unroll
    for (int i = 0; i < 8; ++i) o[i] = (f32x4){0.f, 0.f, 0.f, 0.f};
    const float l2g = __builtin_amdgcn_logf(1.0f - ex2(-5.0f - (float)h));
    const int sr = tid >> 3, sc = tid & 7;
    v4u kreg[4], vreg[4];
#define RET_LOADKV(j) do { const bf16* kp_ = Pb + (size_t)(64 * (j) + sr) * EIN + 1024 + h * 256 + 8 * sc; \
        _Pragma("unroll") for (int i_ = 0; i_ < 4; ++i_) { kreg[i_] = *(const v4u*)(kp_ + 64 * i_); vreg[i_] = *(const v4u*)(kp_ + 1024 + 64 * i_); } } while (0)
    RET_LOADKV(0);
    const int tq = t0 + 16 * tb + c;
    for (int j = 0; j <= qb; ++j) {
        __syncthreads();
#pragma unroll
        for (int i = 0; i < 4; ++i) { *(LAS v4u*)(Ks + sr * LST256 + (sc + 8 * i) * 16) = kreg[i]; *(LAS v4u*)(Vs + sr * LST256 + (sc + 8 * i) * 16) = vreg[i]; }
        __syncthreads();
        if (j < qb) RET_LOADKV(j + 1);
        f32x4 pt[4];
#pragma unroll
        for (int a = 0; a < 4; ++a) { pt[a] = (f32x4){0.f, 0.f, 0.f, 0.f};
#pragma unroll
            for (int ks = 0; ks < 8; ++ks) { const bf16x8 kf = *(const LAS bf16x8*)(Ks + (16 * a + c) * LST256 + (32 * ks + 8 * kq) * 2); pt[a] = MFMA16(kf, qf[ks], pt[a]); } }
#pragma unroll
        for (int a = 0; a < 4; ++a)
#pragma unroll
            for (int i = 0; i < 4; ++i) { const int dd = tq - (64 * j + 16 * a + 4 * kq + i); pt[a][i] = dd >= 0 ? pt[a][i] * ex2((float)dd * l2g) : 0.f; }
#pragma unroll
        for (int pr = 0; pr < 2; ++pr) { const bf16x8 pa = pack8(pt[2 * pr], pt[2 * pr + 1]);
            const LAS unsigned char* vb = Vs + (32 * pr + 4 * kq + (c >> 2)) * LST256 + (128 * vh + 4 * (c & 3)) * 2;
#pragma unroll
            for (int vt = 0; vt < 8; ++vt) { const bf16x8 bfr = cat44(tr16(vb + vt * 32), tr16(vb + vt * 32 + 16 * LST256)); o[vt] = MFMA16(pa, bfr, o[vt]); } }
    }
#undef RET_LOADKV
    float ss[4];
#pragma unroll
    for (int i = 0; i < 4; ++i) { float s = 0.f;
#pragma unroll
        for (int vt = 0; vt < 8; ++vt) s += o[vt][i] * o[vt][i];
        s += __shfl_xor(s, 1); s += __shfl_xor(s, 2); s += __shfl_xor(s, 4); s += __shfl_xor(s, 8); ss[i] = s; }
    if (c == 0) {
#pragma unroll
        for (int i = 0; i < 4; ++i) red[(tb * 2 + vh) * 16 + 4 * kq + i] = ss[i]; }
    __syncthreads();
#pragma unroll
    for (int i = 0; i < 4; ++i) { const float tot = red[(tb * 2) * 16 + 4 * kq + i] + red[(tb * 2 + 1) * 16 + 4 * kq + i]; const float rstd = __builtin_amdgcn_rsqf(tot * (1.f / 256.f) + NORM_EPS);
        const int row = t0 + 16 * tb + 4 * kq + i;
#pragma unroll
        for (int vt = 0; vt < 8; ++vt) { const int col = h * 256 + 128 * vh + 16 * vt + c; const float gv = bf2f(Pb[(size_t)row * EIN + 3072 + col]);
            MX[(size_t)row * D + col] = (bf16)f2bf(o[vt][i] * rstd * silu(gv)); } }
}

DI void ret_state(const Frame& F, int e, int u) {
    int tid_ = F.tid; asm volatile("" : "+v"(tid_));
    const int tid = tid_, lane = tid & 63, w = __builtin_amdgcn_readfirstlane(tid >> 6), c = lane & 15, kq = lane >> 4;
    const int b = u >> 4, h = (u >> 2) & 3, vq = u & 3;
    ldsp Ks = F.lds, Vs = F.lds + 64 * LST256;
    const bf16* Pb = wsb(F, WS_PB) + (size_t)(b * 2048) * EIN;
    const float gam = 1.0f - ex2(-5.0f - (float)h), l2g = __builtin_amdgcn_logf(gam), cdec = ex2(64.f * l2g);
    f32x4 S[2][4];
#pragma unroll
    for (int a = 0; a < 2; ++a)
#pragma unroll
        for (int v = 0; v < 4; ++v) S[a][v] = (f32x4){0.f, 0.f, 0.f, 0.f};
    const int sr = tid >> 3, sc = tid & 7; const float zeta = ex2((float)(63 - sr) * l2g);
    for (int j = 0; j < 32; ++j) {
        const bf16* kp = Pb + (size_t)(64 * j + sr) * EIN + 1024 + h * 256 + 8 * sc;
        v4u kreg[4];
#pragma unroll
        for (int i = 0; i < 4; ++i) kreg[i] = *(const v4u*)(kp + 64 * i);
        const v4u vr = *(const v4u*)(Pb + (size_t)(64 * j + sr) * EIN + 2048 + h * 256 + 64 * vq + 8 * sc);
        __syncthreads();
#pragma unroll
        for (int i = 0; i < 4; ++i) *(LAS v4u*)(Ks + sr * LST256 + (sc + 8 * i) * 16) = kreg[i];
        { v4u z; z.x = pk2(bflo(vr.x) * zeta, bfhi(vr.x) * zeta); z.y = pk2(bflo(vr.y) * zeta, bfhi(vr.y) * zeta); z.z = pk2(bflo(vr.z) * zeta, bfhi(vr.z) * zeta); z.w = pk2(bflo(vr.w) * zeta, bfhi(vr.w) * zeta);
          *(LAS v4u*)(Vs + sr * LST64 + sc * 16) = z; }
        __syncthreads();
#pragma unroll
        for (int a = 0; a < 2; ++a)
#pragma unroll
            for (int v = 0; v < 4; ++v) S[a][v] = S[a][v] * cdec;
#pragma unroll
        for (int ks = 0; ks < 2; ++ks) {
            bf16x8 af[2], bfr[4];
#pragma unroll
            for (int a = 0; a < 2; ++a) { const LAS unsigned char* p = Ks + (32 * ks + 8 * kq + (c >> 2)) * LST256 + (16 * (2 * w + a) + 4 * (c & 3)) * 2; af[a] = cat44(tr16(p), tr16(p + 4 * LST256)); }
#pragma unroll
            for (int v = 0; v < 4; ++v) { const LAS unsigned char* p = Vs + (32 * ks + 8 * kq + (c >> 2)) * LST64 + (16 * v + 4 * (c & 3)) * 2; bfr[v] = cat44(tr16(p), tr16(p + 4 * LST64)); }
#pragma unroll
            for (int a = 0; a < 2; ++a)
#pragma unroll
                for (int v = 0; v < 4; ++v) S[a][v] = MFMA16(af[a], bfr[v], S[a][v]);
        }
    }
    float* dst = F.out + O_RETP + ((size_t)((e * 4 + b) * 4 + h)) * 65536;
#pragma unroll
    for (int a = 0; a < 2; ++a)
#pragma unroll
        for (int v = 0; v < 4; ++v)
#pragma unroll
            for (int i = 0; i < 4; ++i) dst[(size_t)(16 * (2 * w + a) + 4 * kq + i) * 256 + 64 * vq + 16 * v + c] = S[a][v][i];
}

DI void ret_sample(const Frame& F, const Args& A, int e, int u) {
    int tid_ = F.tid; asm volatile("" : "+v"(tid_));
    const int tid = tid_, lane = tid & 63, w = __builtin_amdgcn_readfirstlane(tid >> 6);
    const int b = u >> 2, h = u & 3;
    LAS float* qf = (LAS float*)F.lds;
    LAS float* kf = qf + 1024; LAS float* vf = kf + 1024; LAS float* part = vf + 1024;
    LAS float* inner = part + 2048;
    LAS float* red = inner + 16;
    const bf16* Pr = wsb(F, WS_PB) + (size_t)(MP + 4 * b) * EIN; bf16* MX = wsb(F, WS_MIX) + (size_t)(MP + 4 * b) * D;
    const float gam = 1.0f - ex2(-5.0f - (float)h), l2g = __builtin_amdgcn_logf(gam);
    __syncthreads();
#pragma unroll
    for (int i = 0; i < 2; ++i) { const int idx = tid + 512 * i, t = idx >> 8, cc = idx & 255; const bf16* pr = Pr + (size_t)t * EIN + h * 256 + cc;
        qf[idx] = bf2f(pr[0]); kf[idx] = bf2f(pr[1024]); vf[idx] = bf2f(pr[2048]); }
    __syncthreads();
#pragma unroll
    for (int i = 0; i < 2; ++i) { const int p = 2 * w + i, t = p >> 2, s = p & 3; float acc = 0.f;
#pragma unroll
        for (int k = 0; k < 4; ++k) acc += qf[t * 256 + lane + 64 * k] * kf[s * 256 + lane + 64 * k];
        acc = wave_sum(acc); if (lane == 0) inner[p] = t >= s ? acc * ex2((float)(t - s) * l2g) : 0.f; }
    const int v = tid & 255, kh = tid >> 8;
    const float* S0 = A.in[2] + ((size_t)((e * 128 + b) * 4 + h)) * 65536 + (size_t)(128 * kh) * 256 + v;
    float* Sn = F.out + O_RETS + ((size_t)((e * 128 + b) * 4 + h)) * 65536 + (size_t)(128 * kh) * 256 + v;
    const float cdec = ex2(4.f * l2g);
    float vz[4], acc[4];
#pragma unroll
    for (int s = 0; s < 4; ++s) { vz[s] = vf[s * 256 + v] * ex2((float)(3 - s) * l2g); acc[s] = 0.f; }
    for (int k0 = 0; k0 < 128; k0 += 8) {
        float s0[8];
#pragma unroll
        for (int i = 0; i < 8; ++i) s0[i] = __builtin_nontemporal_load(S0 + (size_t)(k0 + i) * 256);
#pragma unroll
        for (int i = 0; i < 8; ++i) { const int k = 128 * kh + k0 + i; float sn = cdec * s0[i];
#pragma unroll
            for (int t = 0; t < 4; ++t) { acc[t] += qf[t * 256 + k] * s0[i]; sn += kf[t * 256 + k] * vz[t]; }
            __builtin_nontemporal_store(sn, Sn + (size_t)(k0 + i) * 256); }
    }
#pragma unroll
    for (int t = 0; t < 4; ++t) part[(kh * 4 + t) * 256 + v] = acc[t];
    __syncthreads();
    if (tid < 256) {
        float o[4], ssq[4];
#pragma unroll
        for (int t = 0; t < 4; ++t) { float x = ex2((float)(t + 1) * l2g) * (part[t * 256 + v] + part[(4 + t) * 256 + v]);
#pragma unroll
            for (int s = 0; s < 4; ++s) x += inner[t * 4 + s] * vf[s * 256 + v];
            o[t] = x; ssq[t] = wave_sum(x * x); }
        if (lane == 0) {
#pragma unroll
            for (int t = 0; t < 4; ++t) red[w * 4 + t] = ssq[t]; }
    }
    __syncthreads();
    if (tid < 256) {
#pragma unroll
        for (int t = 0; t < 4; ++t) { const float tot = red[t] + red[4 + t] + red[8 + t] + red[12 + t]; const float rstd = __builtin_amdgcn_rsqf(tot * (1.f / 256.f) + NORM_EPS);
            float x = ex2((float)(t + 1) * l2g) * (part[t * 256 + v] + part[(4 + t) * 256 + v]);
#pragma unroll
            for (int s = 0; s < 4; ++s) x += inner[t * 4 + s] * vf[s * 256 + v];
            const float gv = bf2f(Pr[(size_t)t * EIN + 3072 + h * 256 + v]);
            MX[(size_t)t * D + h * 256 + v] = (bf16)f2bf(x * rstd * silu(gv)); }
    }
}

template <bool SAMPLE> DI void rglru_unit(const Frame& F, const Args& A, int e, int u) {
    int tid_ = F.tid; asm volatile("" : "+v"(tid_));
    const int tid = tid_, lane = tid & 63, w = __builtin_amdgcn_readfirstlane(tid >> 6), c = lane & 15, kq = lane >> 4;
    const int sq = u >> 5, blk = (u >> 2) & 7, qt = u & 3;
    ldsp XC = F.lds;
    LAS float* XCF = (LAS float*)(F.lds + 128 * LST128);
    LAS float* AA = XCF + 4096; LAS float* BB = AA + 4096;
    LAS float* SEGA = BB + 4096; LAS float* SEGB = SEGA + 512;
    LAS float* HC = SEGB + 512;
    const int chb = blk * 128;
    const bf16* Pb = wsb(F, WS_PB); bf16* MX = wsb(F, WS_MIX);
    const size_t row_base = SAMPLE ? (size_t)(MP + 128 * sq) : (size_t)sq * 2048;
    bf16x8 waf[2][4], wxf[2][4];
    { const bf16* wa = wsb(F, WS_RGW) + (size_t)((e * 8 + blk) * 128 + qt * 32 + c) * 128 + 8 * kq; const bf16* wx = wa + 16 * 16384;
#pragma unroll
      for (int jt = 0; jt < 2; ++jt)
#pragma unroll
          for (int ks = 0; ks < 4; ++ks) { waf[jt][ks] = *(const bf16x8*)(wa + jt * 16 * 128 + 32 * ks); wxf[jt][ks] = *(const bf16x8*)(wx + jt * 16 * 128 + 32 * ks); } }
    float bav[2], bxv[2], la0[2];
#pragma unroll
    for (int jt = 0; jt < 2; ++jt) { const int ch = e * 1024 + chb + qt * 32 + 16 * jt + c; bav[jt] = A.in[12][ch]; bxv[jt] = A.in[14][ch];
        const float x = fexp(-A.in[15][ch]); const float sp = x < 0.03f ? x * (1.f - x * (0.5f - x * (0.33333333f - 0.25f * x))) : flog(1.f + x); la0[jt] = -8.0f * sp; }
    const int cg = tid & 15, rg = tid >> 4;
    float cwv[4][8], cbv[8];
    { const float* cw = A.in[9] + (size_t)e * 4 * 1024 + chb + 8 * cg; const float* cb = A.in[10] + (size_t)e * 1024 + chb + 8 * cg;
#pragma unroll
      for (int k = 0; k < 8; ++k) { cbv[k] = cb[k];
#pragma unroll
          for (int j = 0; j < 4; ++j) cwv[j][k] = cw[j * 1024 + k]; } }
    const int sj = tid & 31, sseg = tid >> 5;
    const int sch = chb + qt * 32 + sj;
    __syncthreads();
    if (tid < 64) HC[tid] = 0.f;
    const int ntile = SAMPLE ? 1 : 16;
    float hlast = 0.f;
    for (int tile = 0; tile < ntile; ++tile) {
        const int t0 = 128 * tile;
        {
            float xin[7][8];
            const bf16* xr = Pb + (row_base + t0 + 4 * rg) * EIN + 4096 + chb + 8 * cg;
#pragma unroll
            for (int r7 = 0; r7 < 7; ++r7) {
                if (SAMPLE) {
                    if (r7 < 3) { const float* bp = A.in[4] + ((size_t)((e * 128 + 32 * sq + rg) * 3 + r7)) * 1024 + chb + 8 * cg;
#pragma unroll
                        for (int k = 0; k < 8; ++k) xin[r7][k] = bp[k]; }
                    else { const v4u wv = *(const v4u*)(xr + (size_t)(r7 - 3) * EIN);
                        xin[r7][0] = bflo(wv.x); xin[r7][1] = bfhi(wv.x); xin[r7][2] = bflo(wv.y); xin[r7][3] = bfhi(wv.y); xin[r7][4] = bflo(wv.z); xin[r7][5] = bfhi(wv.z); xin[r7][6] = bflo(wv.w); xin[r7][7] = bfhi(wv.w); }
                } else {
                    const int tt = t0 + 4 * rg + r7 - 3;
                    if (tt >= 0) { const v4u wv = *(const v4u*)(xr + (ptrdiff_t)(r7 - 3) * EIN);
                        xin[r7][0] = bflo(wv.x); xin[r7][1] = bfhi(wv.x); xin[r7][2] = bflo(wv.y); xin[r7][3] = bfhi(wv.y); xin[r7][4] = bflo(wv.z); xin[r7][5] = bfhi(wv.z); xin[r7][6] = bflo(wv.w); xin[r7][7] = bfhi(wv.w); }
                    else {
#pragma unroll
                        for (int k = 0; k < 8; ++k) xin[r7][k] = 0.f; }
                }
            }
#pragma unroll
            for (int rr = 0; rr < 4; ++rr) { float xc[8];
#pragma unroll
                for (int k = 0; k < 8; ++k) xc[k] = cbv[k] + cwv[0][k] * xin[rr][k] + cwv[1][k] * xin[rr + 1][k] + cwv[2][k] * xin[rr + 2][k] + cwv[3][k] * xin[rr + 3][k];
                v4u o; o.x = pk2(xc[0], xc[1]); o.y = pk2(xc[2], xc[3]); o.z = pk2(xc[4], xc[5]); o.w = pk2(xc[6], xc[7]);
                *(LAS v4u*)(XC + (4 * rg + rr) * LST128 + cg * 16) = o;
                if ((cg >> 2) == qt) {
#pragma unroll
                    for (int k = 0; k < 8; ++k) XCF[(4 * rg + rr) * 32 + 8 * (cg & 3) + k] = xc[k]; } }
            if ((cg >> 2) == qt) {
                if (SAMPLE) { float* dst = F.out + O_RGCS + ((size_t)(e * 128 + 32 * sq + rg) * 3) * 1024 + chb + 8 * cg;
#pragma unroll
                    for (int r3 = 0; r3 < 3; ++r3)
#pragma unroll
                        for (int k = 0; k < 8; ++k) dst[r3 * 1024 + k] = xin[4 + r3][k]; }
                else if (tile == 15 && rg == 31) { float* dst = F.out + O_RGCP + ((size_t)(e * 4 + sq) * 3) * 1024 + chb + 8 * cg;
#pragma unroll
                    for (int r3 = 0; r3 < 3; ++r3)
#pragma unroll
                        for (int k = 0; k < 8; ++k) dst[r3 * 1024 + k] = xin[4 + r3][k]; }
            }
        }
        __syncthreads();
        {
            f32x4 ga[2], gx[2];
#pragma unroll
            for (int jt = 0; jt < 2; ++jt) { ga[jt] = (f32x4){0.f, 0.f, 0.f, 0.f}; gx[jt] = (f32x4){0.f, 0.f, 0.f, 0.f}; }
#pragma unroll
            for (int ks = 0; ks < 4; ++ks) { const bf16x8 af = *(const LAS bf16x8*)(XC + (16 * w + c) * LST128 + (32 * ks + 8 * kq) * 2);
#pragma unroll
                for (int jt = 0; jt < 2; ++jt) { ga[jt] = MFMA16(af, waf[jt][ks], ga[jt]); gx[jt] = MFMA16(af, wxf[jt][ks], gx[jt]); } }
#pragma unroll
            for (int jt = 0; jt < 2; ++jt)
#pragma unroll
                for (int i = 0; i < 4; ++i) { const int rl = 16 * w + 4 * kq + i, j = 16 * jt + c;
                    const float r = sigm(ga[jt][i] + bav[jt]), ig = sigm(gx[jt][i] + bxv[jt]); const float la = la0[jt] * r, y = 2.f * la;
                    float mult = sqrtf(-y * (1.f + y * (0.5f + y * (0.16666667f + y * (0.041666667f + y * 0.0083333333f)))));
                    if (!SAMPLE && (t0 + rl) == 0) mult = 1.f;
                    AA[rl * 32 + j] = fexp(la); BB[rl * 32 + j] = XCF[rl * 32 + j] * ig * mult; }
        }
        __syncthreads();
        if (SAMPLE) {
#pragma unroll
            for (int it = 0; it < 2; ++it) { const int bl = sseg + 16 * it, bglob = 32 * sq + bl; float hh = A.in[3][(size_t)(e * 128 + bglob) * 1024 + sch];
#pragma unroll
                for (int t = 0; t < 4; ++t) { const int rl = 4 * bl + t; hh = AA[rl * 32 + sj] * hh + BB[rl * 32 + sj];
                    const size_t row = row_base + rl; const float gr = bf2f(Pb[row * EIN + 5120 + sch]); MX[row * D + 1024 + sch] = (bf16)f2bf(hh * gelu_t(gr)); }
                F.out[O_RGHS + (size_t)(e * 128 + bglob) * 1024 + sch] = hh; }
        } else {
            float av[8], bv[8]; float pa = 1.f, pb = 0.f;
#pragma unroll
            for (int rr = 0; rr < 8; ++rr) { av[rr] = AA[(8 * sseg + rr) * 32 + sj]; bv[rr] = BB[(8 * sseg + rr) * 32 + sj]; pb = av[rr] * pb + bv[rr]; pa *= av[rr]; }
            SEGA[sseg * 32 + sj] = pa; SEGB[sseg * 32 + sj] = pb;
            __syncthreads();
            float hh = HC[(tile & 1) * 32 + sj];
            for (int s2 = 0; s2 < sseg; ++s2) hh = SEGA[s2 * 32 + sj] * hh + SEGB[s2 * 32 + sj];
#pragma unroll
            for (int rr = 0; rr < 8; ++rr) { hh = av[rr] * hh + bv[rr]; const size_t row = row_base + t0 + 8 * sseg + rr;
                const float gr = bf2f(Pb[row * EIN + 5120 + sch]); MX[row * D + 1024 + sch] = (bf16)f2bf(hh * gelu_t(gr)); }
            if (sseg == 15) { HC[((tile + 1) & 1) * 32 + sj] = hh; hlast = hh; }
        }
        __syncthreads();
    }
    if (!SAMPLE && sseg == 15) F.out[O_RGHP + (size_t)(e * 4 + sq) * 1024 + sch] = hlast;
}

DI float hg_lb(const Args& A, int o, int col) { if (o == 0) return 0.f; return sigm(A.in[19][2048 + col] - A.in[19][col]); }

DI void gla_prompt(const Frame& F, const Args& A, int o, int u) {
    int tid_ = F.tid; asm volatile("" : "+v"(tid_));
    const int tid = tid_, lane = tid & 63, w = __builtin_amdgcn_readfirstlane(tid >> 6), tb = w >> 1, vh = w & 1, c = lane & 15, kq = lane >> 4;
    const int b = u >> 4, h = u & 15;
    constexpr int TB = 64 * LST128;
    ldsp QP = F.lds, KP = F.lds + TB, QS = F.lds + 2 * TB, KL = F.lds + 3 * TB, VS = F.lds + 4 * TB, ST = F.lds + 5 * TB;
    LAS float* SEGT = (LAS float*)(F.lds + 5 * TB + 128 * LST128);
    LAS float* EB = SEGT + 512;
    LAS float* red = EB + 128;
    const bf16* Pb = wsb(F, WS_PB) + (size_t)(b * 2048) * OIN; bf16* MX = wsb(F, WS_MIX) + (size_t)(b * 2048) * D;
    const int ek = tid & 127, eseg = tid >> 7;
    const float lbv = hg_lb(A, o, h * 128 + ek);
    f32x4 S[8];
#pragma unroll
    for (int v = 0; v < 8; ++v) S[v] = (f32x4){0.f, 0.f, 0.f, 0.f};
    __syncthreads();
    for (int i = tid; i < 128 * LST128 / 4; i += NTHR) ((LAS unsigned*)ST)[i] = 0u;
    float ngv[4];
#pragma unroll
    for (int vt = 0; vt < 4; ++vt) ngv[vt] = A.in[18][o * 128 + 64 * vh + 16 * vt + c];
    const int sr = tid >> 3, sc = tid & 7;
    for (int n = 0; n < 32; ++n) {
        const int t0 = 64 * n;
        float bl[16], kk[16], qs[16]; float cum = 0.f;
        { const bf16* pq = Pb + (size_t)(t0 + 16 * eseg) * OIN + h * 128 + ek;
#pragma unroll
          for (int rr = 0; rr < 16; ++rr) { const float qv = bf2f(pq[(size_t)rr * OIN]), fv = bf2f(pq[(size_t)rr * OIN + 2048]);
              const float fg = lbv + (1.f - lbv) * sigm(fv); cum += flog(fg); bl[rr] = cum; kk[rr] = 1.f - fg; qs[rr] = silu(qv); } }
        const v4u vr0 = *(const v4u*)(Pb + (size_t)(t0 + sr) * OIN + 4096 + h * 128 + 8 * sc), vr1 = *(const v4u*)(Pb + (size_t)(t0 + sr) * OIN + 4096 + h * 128 + 64 + 8 * sc);
        SEGT[eseg * 128 + ek] = cum;
        __syncthreads();
        { const float s0 = SEGT[ek], s1 = SEGT[128 + ek], s2 = SEGT[256 + ek], s3 = SEGT[384 + ek];
          const float pre = eseg == 0 ? 0.f : (eseg == 1 ? s0 : (eseg == 2 ? s0 + s1 : s0 + s1 + s2));
          const float bref = s0 + s1, blast = bref + s2 + s3; const float eref = fexp(bref), elast = fexp(blast - bref);
          if (eseg == 0) EB[ek] = fexp(blast);
#pragma unroll
          for (int rr = 0; rr < 16; ++rr) { const float bt = pre + bl[rr]; const float e1 = fexp(bt - bref), e2 = fexp(bref - bt); const float q1 = qs[rr] * e1, k1 = kk[rr] * e2;
              const int off = (16 * eseg + rr) * LST128 + ek * 2;
              *(LAS bf16*)(QP + off) = (bf16)f2bf(q1); *(LAS bf16*)(KP + off) = (bf16)f2bf(k1); *(LAS bf16*)(QS + off) = (bf16)f2bf(q1 * eref); *(LAS bf16*)(KL + off) = (bf16)f2bf(k1 * elast); } }
        *(LAS v4u*)(VS + sr * LST128 + sc * 16) = vr0; *(LAS v4u*)(VS + sr * LST128 + 128 + sc * 16) = vr1;
        __syncthreads();
        f32x4 ov[4];
#pragma unroll
        for (int vt = 0; vt < 4; ++vt) ov[vt] = (f32x4){0.f, 0.f, 0.f, 0.f};
        {
            bf16x8 qf[4];
#pragma unroll
            for (int ks = 0; ks < 4; ++ks) qf[ks] = *(const LAS bf16x8*)(QP + (16 * tb + c) * LST128 + (32 * ks + 8 * kq) * 2);
            f32x4 pt[4];
#pragma unroll
            for (int a = 0; a < 4; ++a) { pt[a] = (f32x4){0.f, 0.f, 0.f, 0.f};
#pragma unroll
                for (int ks = 0; ks < 4; ++ks) { const bf16x8 kf = *(const LAS bf16x8*)(KP + (16 * a + c) * LST128 + (32 * ks + 8 * kq) * 2); pt[a] = MFMA16(kf, qf[ks], pt[a]); }
#pragma unroll
                for (int i = 0; i < 4; ++i) pt[a][i] = (16 * a + 4 * kq + i) <= (16 * tb + c) ? pt[a][i] : 0.f; }
#pragma unroll
            for (int pr = 0; pr < 2; ++pr) { const bf16x8 pa = pack8(pt[2 * pr], pt[2 * pr + 1]);
                const LAS unsigned char* vb = VS + (32 * pr + 4 * kq + (c >> 2)) * LST128 + (64 * vh + 4 * (c & 3)) * 2;
#pragma unroll
                for (int vt = 0; vt < 4; ++vt) { const bf16x8 bfr = cat44(tr16(vb + vt * 32), tr16(vb + vt * 32 + 16 * LST128)); ov[vt] = MFMA16(pa, bfr, ov[vt]); } }
#pragma unroll
            for (int ks = 0; ks < 4; ++ks) { const bf16x8 af = *(const LAS bf16x8*)(QS + (16 * tb + c) * LST128 + (32 * ks + 8 * kq) * 2);
#pragma unroll
                for (int vt = 0; vt < 4; ++vt) { const bf16x8 bfr = *(const LAS bf16x8*)(ST + (64 * vh + 16 * vt + c) * LST128 + (32 * ks + 8 * kq) * 2); ov[vt] = MFMA16(af, bfr, ov[vt]); } }
        }
        float ss[4];
#pragma unroll
        for (int i = 0; i < 4; ++i) { float s = 0.f;
#pragma unroll
            for (int vt = 0; vt < 4; ++vt) s += ov[vt][i] * ov[vt][i];
            s += __shfl_xor(s, 1); s += __shfl_xor(s, 2); s += __shfl_xor(s, 4); s += __shfl_xor(s, 8); ss[i] = s; }
        if (c == 0) {
#pragma unroll
            for (int i = 0; i < 4; ++i) red[(tb * 2 + vh) * 16 + 4 * kq + i] = ss[i]; }
        __syncthreads();
#pragma unroll
        for (int i = 0; i < 4; ++i) { const float tot = red[(tb * 2) * 16 + 4 * kq + i] + red[(tb * 2 + 1) * 16 + 4 * kq + i]; const float rstd = __builtin_amdgcn_rsqf(tot * (1.f / 128.f) + NORM_EPS);
            const int row = t0 + 16 * tb + 4 * kq + i;
#pragma unroll
            for (int vt = 0; vt < 4; ++vt) { const int col = h * 128 + 64 * vh + 16 * vt + c; const float gv = bf2f(Pb[(size_t)row * OIN + 6144 + col]);
                MX[(size_t)row * D + col] = (bf16)f2bf(ov[vt][i] * rstd * ngv[vt] * sigm(gv)); } }
        {
            f32x4 eb;
#pragma unroll
            for (int i = 0; i < 4; ++i) eb[i] = EB[16 * w + 4 * kq + i];
#pragma unroll
            for (int v = 0; v < 8; ++v) S[v] = S[v] * eb;
#pragma unroll
            for (int ks = 0; ks < 2; ++ks) { const LAS unsigned char* pk = KL + (32 * ks + 8 * kq + (c >> 2)) * LST128 + (16 * w + 4 * (c & 3)) * 2; const bf16x8 af = cat44(tr16(pk), tr16(pk + 4 * LST128));
                const LAS unsigned char* pv = VS + (32 * ks + 8 * kq + (c >> 2)) * LST128 + (4 * (c & 3)) * 2;
#pragma unroll
                for (int v = 0; v < 8; ++v) { const bf16x8 bfr = cat44(tr16(pv + v * 32), tr16(pv + v * 32 + 4 * LST128)); S[v] = MFMA16(af, bfr, S[v]); } }
#pragma unroll
            for (int v = 0; v < 8; ++v) { v2u wv; wv.x = pg8::cvt_pk_bf16(S[v][0], S[v][1]); wv.y = pg8::cvt_pk_bf16(S[v][2], S[v][3]); *(LAS v2u*)(ST + (16 * v + c) * LST128 + (16 * w + 4 * kq) * 2) = wv; }
        }
    }
    float* dst = F.out + O_HGP + ((size_t)((o * 4 + b) * 16 + h)) * 16384;
#pragma unroll
    for (int v = 0; v < 8; ++v)
#pragma unroll
        for (int i = 0; i < 4; ++i) dst[(size_t)(16 * w + 4 * kq + i) * 128 + 16 * v + c] = S[v][i];
}

DI void gla_sample(const Frame& F, const Args& A, int o, int u) {
    int tid_ = F.tid; asm volatile("" : "+v"(tid_));
    const int tid = tid_, lane = tid & 63, w = __builtin_amdgcn_readfirstlane(tid >> 6);
    const int b = u >> 2, hq = u & 3;
    LAS float* fq = (LAS float*)F.lds;
    LAS float* fk = fq + 512; LAS float* fs = fk + 512; LAS float* part = fs + 512;
    LAS float* red = part + 2048;
    const bf16* Pr = wsb(F, WS_PB) + (size_t)(MP + 4 * b) * OIN; bf16* MX = wsb(F, WS_MIX) + (size_t)(MP + 4 * b) * D;
    for (int hh = 0; hh < 4; ++hh) {
        const int h = hq * 4 + hh;
        __syncthreads();
        { const int t = tid >> 7, k = tid & 127; const float lbv = hg_lb(A, o, h * 128 + k);
          const float qv = bf2f(Pr[(size_t)t * OIN + h * 128 + k]), fv = bf2f(Pr[(size_t)t * OIN + 2048 + h * 128 + k]);
          const float fg = lbv + (1.f - lbv) * sigm(fv); fq[tid] = fg; fk[tid] = 1.f - fg; fs[tid] = silu(qv); }
        __syncthreads();
        const int v = tid & 127, kg = tid >> 7;
        const float* S0 = A.in[5] + ((size_t)((o * 128 + b) * 16 + h)) * 16384 + (size_t)(32 * kg) * 128 + v;
        float* Sn = F.out + O_HGS + ((size_t)((o * 128 + b) * 16 + h)) * 16384 + (size_t)(32 * kg) * 128 + v;
        float s[32];
#pragma unroll
        for (int i = 0; i < 32; ++i) s[i] = __builtin_nontemporal_load(S0 + (size_t)i * 128);
        float iv[4], acc[4];
#pragma unroll
        for (int t = 0; t < 4; ++t) { iv[t] = bf2f(Pr[(size_t)t * OIN + 4096 + h * 128 + v]); acc[t] = 0.f; }
#pragma unroll
        for (int t = 0; t < 4; ++t)
#pragma unroll
            for (int i = 0; i < 32; ++i) { const int k = 32 * kg + i; s[i] = fq[t * 128 + k] * s[i] + fk[t * 128 + k] * iv[t]; acc[t] += s[i] * fs[t * 128 + k]; }
#pragma unroll
        for (int i = 0; i < 32; ++i) __builtin_nontemporal_store(s[i], Sn + (size_t)i * 128);
#pragma unroll
        for (int t = 0; t < 4; ++t) part[(kg * 4 + t) * 128 + v] = acc[t];
        __syncthreads();
        float ot[4];
        if (tid < 128) {
#pragma unroll
            for (int t = 0; t < 4; ++t) { ot[t] = part[t * 128 + v] + part[(4 + t) * 128 + v] + part[(8 + t) * 128 + v] + part[(12 + t) * 128 + v]; const float q = wave_sum(ot[t] * ot[t]); if (lane == 0) red[w * 4 + t] = q; }
        }
        __syncthreads();
        if (tid < 128) { const float ng = A.in[18][o * 128 + v];
#pragma unroll
            for (int t = 0; t < 4; ++t) { const float rstd = __builtin_amdgcn_rsqf((red[t] + red[4 + t]) * (1.f / 128.f) + NORM_EPS); const float gv = bf2f(Pr[(size_t)t * OIN + 6144 + h * 128 + v]);
                MX[(size_t)t * D + h * 128 + v] = (bf16)f2bf(ot[t] * rstd * ng * sigm(gv)); } }
    }
}

__global__ void __launch_bounds__(NTHR, 2) mega(Args args) {
    extern __shared__ __attribute__((aligned(16))) unsigned char lds_raw[];
    Frame F;
    F.lds = (ldsp)lds_raw; F.MISC = (volatile LAS unsigned*)(F.lds + MISC_OFF);
    F.tid = threadIdx.x; F.lane = F.tid & 63; F.wave = __builtin_amdgcn_readfirstlane(F.tid >> 6);
    F.G = gridDim.x; { const int bx = blockIdx.x; F.vcu = (F.G % 8 == 0) ? (bx % 8) * (F.G / 8) + bx / 8 : bx; }
    F.ws = args.ws; F.out = args.out; F.ctl = (gu32*)(args.ws + WS_CTL);
    if (F.tid < 32) F.MISC[F.tid] = 0u;
    __syncthreads();
    const int lo = args.ph_lo, hi = args.ph_hi;
    XcdBarrier bar; bar.bar = (unsigned*)(F.ctl + CW_BAR); bar.x = 0; bar.st = F.MISC + 8;
    if (hi - lo > 1) bar = xcd_barrier_post((unsigned*)(F.ctl + CW_BAR), F.MISC + 8);
#define IN(k) (lo <= (k) && (k) < hi)
#ifndef EN_MASK
#define EN_MASK 0xffff
#endif
#define EN(i) ((EN_MASK >> (i)) & 1)
#define PF(Fp) Frame Fp = F; asm volatile("" : "+v"(Fp.tid)); Fp.lane = Fp.tid & 63; Fp.wave = __builtin_amdgcn_readfirstlane(Fp.tid >> 6)
#define SEAM(k) do { if ((k) + 1 < hi) xcd_barrier(bar); } while (0)

    if (IN(0)) { PF(Fp); if (EN(0)) p0_prologue(Fp, args); SEAM(0); }

    for (int l = 0; l < 4; ++l) {
        const int pb = 1 + 8 * l, e = l >> 1;
        if (IN(pb)) {
            if ((l & 1) == 0) { if (EN(1)) {
                pg8::Gemm g{wsb(F, WS_XN), wsb(F, WS_WINE) + (size_t)e * EIN * D, M, EIN, D}; pg8::StaticOrder S; S.init(M, EIN, F.G, (int)blockIdx.x);
                pg8::EpiEvenIn E{wsb(F, WS_PB), EIN, wsf(F, WS_ROT), wsf(F, WS_ROT) + 2052 * 128};
                pg8::gemm_phase<pg8::EpiEvenIn, pg8::StaticOrder, true, true>(F.lds, g, S, E); }
            } else if (EN(2)) {
                pg8::Gemm g{wsb(F, WS_XN), wsb(F, WS_WINO) + (size_t)e * OIN * D, M, OIN, D}; pg8::StaticOrder S; S.init(M, OIN, F.G, (int)blockIdx.x);
                pg8::EpiBf16<0> E{wsb(F, WS_PB), OIN, nullptr, 0, 0, 1.f};
                pg8::gemm_phase<pg8::EpiBf16<0>, pg8::StaticOrder, true, true>(F.lds, g, S, E);
            }
            SEAM(pb);
        }
        if (IN(pb + 1)) {
            PF(Fp);
            if ((l & 1) == 0) {
                if (EN(3)) for (int u; (u = q_next(Fp, 8 * l + 0)) < 128;) rglru_unit<false>(Fp, args, e, u);
                if (EN(4)) for (int u; (u = q_next(Fp, 8 * l + 1)) < 256;) { const int b = u >> 6, h = (u >> 4) & 3, qb = u & 15; ret_flash(Fp, b, h, qb); ret_flash(Fp, b, h, 31 - qb); }
                if (EN(5)) for (int u; (u = q_next(Fp, 8 * l + 2)) < 512;) ret_sample(Fp, args, e, u);
                if (EN(6)) for (int u; (u = q_next(Fp, 8 * l + 3)) < 64;) ret_state(Fp, e, u);
                if (EN(7)) for (int u; (u = q_next(Fp, 8 * l + 4)) < 128;) rglru_unit<true>(Fp, args, e, u);
            } else {
                if (EN(8)) for (int u; (u = q_next(Fp, 8 * l + 0)) < 64;) gla_prompt(Fp, args, e, u);
                if (EN(9)) for (int u; (u = q_next(Fp, 8 * l + 1)) < 512;) gla_sample(Fp, args, e, u);
            }
            SEAM(pb + 1);
        }
        if (IN(pb + 2)) { if (EN(10)) {
            const bf16* wt = (l & 1) ? wsb(F, WS_WOUTO) + (size_t)e * D * D : wsb(F, WS_WOUTE) + (size_t)e * D * D;
            pg8::Gemm g{wsb(F, WS_MIX), wt, M, D, D}; pg8::StaticOrder S; S.init(M, D, F.G, (int)blockIdx.x);
            pg8::EpiF32 E{wsf(F, WS_Y), D, nullptr};
            pg8::gemm_phase<pg8::EpiF32, pg8::StaticOrder, true, true>(F.lds, g, S, E); }
            SEAM(pb + 2);
        }
        if (IN(pb + 3)) { PF(Fp); if (EN(11)) ln_phase(Fp, args.in[20] + (size_t)(l * 2) * D, args.in[21] + (size_t)(l * 2) * D, nullptr); SEAM(pb + 3); }
        if (IN(pb + 4)) { if (EN(12)) {
            pg8::Gemm g{wsb(F, WS_XN), wsb(F, WS_WUP) + (size_t)l * NUP * D, M, NUP, D}; pg8::StaticOrder S; S.init(M, NUP, F.G, (int)blockIdx.x);
            pg8::EpiBf16<0> E{wsb(F, WS_UV), NUP, nullptr, 0, 0, 1.f};
            pg8::gemm_phase<pg8::EpiBf16<0>, pg8::StaticOrder, true, true>(F.lds, g, S, E); }
            SEAM(pb + 4);
        }
        if (IN(pb + 5)) { PF(Fp); if (EN(13)) hph_phase(Fp, args, l); SEAM(pb + 5); }
        if (IN(pb + 6)) { if (EN(14)) {
            pg8::Gemm g{wsb(F, WS_H), wsb(F, WS_WDOWN) + (size_t)l * D * DFF, M, D, DFF}; pg8::StaticOrder S; S.init(M, D, F.G, (int)blockIdx.x);
            pg8::EpiF32 E{wsf(F, WS_Y), D, nullptr};
            pg8::gemm_phase<pg8::EpiF32, pg8::StaticOrder, true, true>(F.lds, g, S, E); }
            SEAM(pb + 6);
        }
        if (IN(pb + 7)) { PF(Fp); if (EN(15)) ln_phase(Fp, args.in[20] + (size_t)(l * 2 + 1) * D, args.in[21] + (size_t)(l * 2 + 1) * D, l == 3 ? F.out + O_YP : nullptr); SEAM(pb + 7); }
    }
#undef IN
#undef SEAM
}

extern "C" void kernel_launch(void* const* d_in, const int* in_sizes, int n_in, void* d_out, int out_size, void* d_ws, size_t ws_size, hipStream_t stream) {
    static int grid = 0;
    if (grid == 0) {
        if (n_in != 26 || (size_t)out_size != O_END || ws_size < WS_END) { fprintf(stderr, "kernel_launch: unexpected problem (n_in %d, out %d, ws %zu); nothing launched\n", n_in, out_size, ws_size); grid = -1; return; }
        int dev = 0, cus = 0, per_cu = 0;
        if (hipGetDevice(&dev) != hipSuccess || hipDeviceGetAttribute(&cus, hipDeviceAttributeMultiprocessorCount, dev) != hipSuccess) { grid = -1; return; }
        if (hipFuncSetAttribute((const void*)mega, hipFuncAttributeMaxDynamicSharedMemorySize, LDS_BYTES) != hipSuccess) { fprintf(stderr, "kernel_launch: hipFuncSetAttribute failed\n"); grid = -1; return; }
        if (hipOccupancyMaxActiveBlocksPerMultiprocessor(&per_cu, (const void*)mega, NTHR, LDS_BYTES) != hipSuccess || per_cu < 1) { fprintf(stderr, "kernel_launch: occupancy query reports %d workgroups per CU\n", per_cu); }
        (void)hipGetLastError();
        grid = cus;
    }
    if (grid < 0) return;
    if (hipMemsetAsync((char*)d_ws + WS_CTL, 0, CTL_ZERO_BYTES, stream) != hipSuccess) return;
    Args a{};
    for (int i = 0; i < 26; ++i) a.in[i] = (const float*)d_in[i];
    a.out = (float*)d_out; a.ws = (unsigned char*)d_ws;
#if MK_PER_PHASE
    for (int p = 0; p < NPH; ++p) { a.ph_lo = p; a.ph_hi = p + 1; hipLaunchKernelGGL(mega, dim3(grid), dim3(NTHR), LDS_BYTES, stream, a); }
#else
    a.ph_lo = 0; a.ph_hi = NPH; hipLaunchKernelGGL(mega, dim3(grid), dim3(NTHR), LDS_BYTES, stream, a);
#endif
    const hipError_t le = hipPeekAtLastError();
    if (le != hipSuccess) fprintf(stderr, "kernel_launch: launch failed: %s\n", hipGetErrorName(le));
}
```
